# Optimizing an MI355X kernel written in HIP

```python
import jax, jax.numpy as jnp
from jax import lax
import numpy as np

D_MODEL = 1024
BATCH = 16
SEQ = 2048
DEPTH = 4

CTX_LEN = 256
GRID_W = 64
N_MOD = 9
EPS = 1e-6
FFN_RESIDUAL = 0.5
D_FF = 2816
HEAD_DIM = 64
ROPE_PAIRS = HEAD_DIM // 4
ROPE_THETA = 10000.0
BLOCK = 128
A_HEADS = 8
A_KV = 2
WINDOW = 128
B_HEADS = 8
B_KV = 2
C_HEADS = 4
C_HEAD_DIM = 128
C_CONV = 5
MLSTM_CHUNK = 64
F_BIAS_LO = 3.0
F_BIAS_HI = 6.0
A_WIDTH = A_HEADS * HEAD_DIM
A_KV_WIDTH = A_KV * HEAD_DIM
B_WIDTH = B_HEADS * HEAD_DIM
B_KV_WIDTH = B_KV * HEAD_DIM
C_WIDTH = C_HEADS * C_HEAD_DIM
BRANCH_WIDTH = 512
N_BRANCH = 3
IN_SIZES = (A_WIDTH, A_KV_WIDTH, A_KV_WIDTH, B_WIDTH, B_KV_WIDTH, B_KV_WIDTH, C_WIDTH, C_WIDTH, C_WIDTH, C_WIDTH, 4 * C_HEADS, N_BRANCH * D_MODEL)
IN_WIDTH = sum(IN_SIZES)

kernel_name = 'hybrid_diffusion_trunk'


def rms_norm(x, g):
    xf = x.astype(jnp.float32)
    y = xf * lax.rsqrt(jnp.mean(xf * xf, axis=-1, keepdims=True) + EPS)
    return (y * g.astype(jnp.float32)).astype(x.dtype)


def swiglu(x, w_gate, w_up, w_down):
    return (jax.nn.silu(x @ w_gate) * (x @ w_up)) @ w_down


def modulated_norm(x, mod, k, norm_g):
    return rms_norm(x, norm_g[2 * k]) * (1 + mod[:, :, 3 * k + 1]) + mod[:, :, 3 * k]


def gated_residual(x, y, mod, k, norm_g, weight):
    return x + weight * mod[:, :, 3 * k + 2] * rms_norm(y, norm_g[2 * k + 1])


def half_ffn(x, mod, k, norm_g, w):
    h = modulated_norm(x, mod, k, norm_g)
    return gated_residual(x, swiglu(h, *w), mod, k, norm_g, FFN_RESIDUAL)


def split_columns(p):
    outs, start = [], 0
    for size in IN_SIZES:
        outs.append(p[..., start:start + size])
        start += size
    return outs


def heads(t, n):
    return t.reshape(t.shape[:-1] + (n, -1))


def group(t, kv):
    return t.reshape(t.shape[:2] + (kv, -1, t.shape[-1]))


def axial_rope_tables(rows):
    row = jnp.repeat(jnp.arange(rows), GRID_W)
    col = jnp.tile(jnp.arange(GRID_W), rows)
    freqs = ROPE_THETA ** (-jnp.arange(ROPE_PAIRS, dtype=jnp.float32) / ROPE_PAIRS)
    ang = jnp.stack([row[:, None] * freqs, col[:, None] * freqs], axis=1)
    return jnp.cos(ang), jnp.sin(ang)


def apply_rope(x, cos, sin):
    xs = x.astype(jnp.float32).reshape(x.shape[:-1] + (2, 2, ROPE_PAIRS))
    x1, x2 = xs[..., 0, :], xs[..., 1, :]
    c, s = cos[None, :, None], sin[None, :, None]
    out = jnp.stack([x1 * c - x2 * s, x2 * c + x1 * s], axis=-2)
    return out.reshape(x.shape).astype(x.dtype)


def gqa_softmax(q, k, v, mask, sink):
    kv, g = q.shape[2], q.shape[3]
    s = jnp.einsum('bqkgd,bskd->bkgqs', q, k).astype(jnp.float32) * (q.shape[-1] ** -0.5)
    if mask is not None:
        s = jnp.where(mask, s, -jnp.inf)
    if sink is not None:
        sink_col = jnp.broadcast_to(sink.astype(jnp.float32).reshape(1, kv, g, 1, 1), s.shape[:-1] + (1,))
        p = jax.nn.softmax(jnp.concatenate([s, sink_col], axis=-1), axis=-1)[..., :-1]
    else:
        p = jax.nn.softmax(s, axis=-1)
    o = jnp.einsum('bkgqs,bskd->bqkgd', p.astype(v.dtype), v)
    return o.reshape(o.shape[:2] + (-1,))


def blockwise_queries(fn, q):
    bsz, t_lat = q.shape[:2]
    nb = t_lat // BLOCK
    qb = jnp.swapaxes(q.reshape((bsz, nb, BLOCK) + q.shape[2:]), 0, 1)
    out = lax.map(fn, (qb, jnp.arange(nb)))
    return jnp.swapaxes(out, 0, 1).reshape(bsz, t_lat, -1)


def windowed_attention(q, k, v, k_ctx, v_ctx, sink):
    t_lat, t_ctx = q.shape[1], k_ctx.shape[1]
    span = BLOCK + 2 * WINDOW
    pad = ((0, 0), (WINDOW, WINDOW), (0, 0), (0, 0))
    kp, vp = jnp.pad(k, pad), jnp.pad(v, pad)
    r, j = jnp.arange(BLOCK), jnp.arange(span)
    near = jnp.abs(r[:, None] + WINDOW - j[None, :]) <= WINDOW
    ctx_cols = jnp.ones((BLOCK, t_ctx), bool)

    def one_block(args):
        qi, i = args
        start = i * BLOCK
        kw = lax.dynamic_slice_in_dim(kp, start, span, axis=1)
        vw = lax.dynamic_slice_in_dim(vp, start, span, axis=1)
        s_pos = start - WINDOW + j
        in_range = (s_pos >= 0) & (s_pos < t_lat)
        mask = jnp.concatenate([ctx_cols, near & in_range[None, :]], axis=1)
        return gqa_softmax(qi, jnp.concatenate([k_ctx, kw], axis=1), jnp.concatenate([v_ctx, vw], axis=1), mask, sink)

    return blockwise_queries(one_block, q)


def dense_attention(q, k_all, v_all):
    return blockwise_queries(lambda args: gqa_softmax(args[0], k_all, v_all, None, None), q)


def centred_conv(x, w, b):
    y = lax.conv_general_dilated(x, w[:, None, :].astype(x.dtype), window_strides=(1,),
                                 padding=[(C_CONV // 2, C_CONV // 2)],
                                 dimension_numbers=('NWC', 'WIO', 'NWC'), feature_group_count=x.shape[-1])
    return y + b


def mlstm_scan(q, k, v, li, lf, state):
    bsz, nh, t_len, dk = q.shape
    nc = t_len // MLSTM_CHUNK

    def chunks(t):
        t = t.astype(jnp.float32).reshape((bsz, nh, nc, MLSTM_CHUNK) + t.shape[3:])
        return jnp.moveaxis(t, 2, 0)

    causal = jnp.tril(jnp.ones((MLSTM_CHUNK, MLSTM_CHUNK), bool))

    def step(carry, inp):
        C, n, m = carry
        qc, kc, vc, ic, fc = inp
        b = jnp.cumsum(fc, axis=-1)
        d_log = jnp.where(causal, b[..., :, None] - b[..., None, :] + ic[..., None, :], -jnp.inf)
        inter = b + m[..., None]
        m_t = jnp.maximum(inter, jnp.max(d_log, axis=-1))
        w_intra = jnp.exp(d_log - m_t[..., None])
        w_inter = jnp.exp(inter - m_t)
        s = jnp.einsum('bhtd,bhsd->bhts', qc, kc) * w_intra
        num = jnp.einsum('bhts,bhsv->bhtv', s, vc) + w_inter[..., None] * jnp.einsum('bhtd,bhdv->bhtv', qc, C)
        den = jnp.sum(s, axis=-1) + w_inter * jnp.einsum('bhtd,bhd->bht', qc, n)
        h = num / jnp.maximum(jnp.abs(den), jnp.exp(-m_t))[..., None]
        m_new = m_t[..., -1]
        w_end = jnp.exp(b[..., -1:] - b + ic - m_new[..., None])
        decay = jnp.exp(b[..., -1] + m - m_new)
        C = decay[..., None, None] * C + jnp.einsum('bhs,bhsd,bhsv->bhdv', w_end, kc, vc)
        n = decay[..., None] * n + jnp.einsum('bhs,bhsd->bhd', w_end, kc)
        return (C, n, m_new), h

    state, h = lax.scan(step, state, (chunks(q) * (dk ** -0.5), chunks(k), chunks(v), chunks(li), chunks(lf)))
    h = jnp.moveaxis(h, 0, 2).reshape(bsz, nh, t_len, -1)
    return h.astype(v.dtype), state


def mlstm_prep(q, k, v, g, conv_w, conv_b, gate_b):
    qk = jax.nn.silu(centred_conv(jnp.concatenate([q, k], axis=-1), conv_w, conv_b))
    q, k = jnp.split(qk, 2, axis=-1)
    q, k, v = (jnp.transpose(heads(t, C_HEADS), (0, 2, 1, 3)) for t in (q, k, v))
    gp = jnp.transpose((g + gate_b).astype(jnp.float32), (0, 2, 1))
    i_f, f_f, i_b, f_b = jnp.split(gp, 4, axis=1)
    fwd = (q, k, v, i_f, jax.nn.log_sigmoid(f_f))
    bwd = tuple(jnp.flip(t, axis=2) for t in (q, k, v, i_b, jax.nn.log_sigmoid(f_b)))
    return fwd, bwd


def mlstm_mixer(lat, ctx_in, need_ctx, conv_w, conv_b, gate_b, head_g):
    q, k, v, o, g = lat
    qc, kc, vc, oc, gc = ctx_in
    fwd, bwd = mlstm_prep(q, k, v, g, conv_w, conv_b, gate_b)
    fwd_c, bwd_c = mlstm_prep(qc, kc, vc, gc, conv_w, conv_b, gate_b)
    bsz = q.shape[0]
    zero = (jnp.zeros((bsz, C_HEADS, C_HEAD_DIM, C_HEAD_DIM), jnp.float32),
            jnp.zeros((bsz, C_HEADS, C_HEAD_DIM), jnp.float32),
            jnp.zeros((bsz, C_HEADS), jnp.float32))
    h_cf, st_f = mlstm_scan(*fwd_c, zero)
    h_cb, st_b = mlstm_scan(*bwd_c, zero)
    h_f, _ = mlstm_scan(*fwd, st_f)
    h_b, _ = mlstm_scan(*bwd, st_b)

    def readout(h, og):
        h = rms_norm(jnp.transpose(h, (0, 2, 1, 3)), head_g.reshape(C_HEADS, C_HEAD_DIM))
        return jax.nn.sigmoid(og) * h.reshape(h.shape[:2] + (C_WIDTH,))

    y = readout(h_f + jnp.flip(h_b, axis=2), o)
    if not need_ctx:
        return y, None
    return y, readout(h_cf + jnp.flip(h_cb, axis=2), oc)


def merge(y_a, y_b, y_m, gate_logits, w_branch, w_out):
    y = jnp.stack([y_a, y_b, y_m], axis=-2)
    z = jnp.einsum('btnw,nwd->btnd', y, w_branch)
    g = jax.nn.sigmoid(gate_logits.reshape(gate_logits.shape[:-1] + (N_BRANCH, D_MODEL)))
    return jnp.sum(g * z, axis=-2) @ w_out


def token_mixers(h, hc, need_ctx, cos, sin, w_in, attn_sink, qk_norm_g, conv_w, conv_b, gate_b, head_g, w_branch, w_out):
    qa, ka, va, qb, kb, vb, qm, km, vm, om, gm, gl = split_columns(h @ w_in)
    qa_c, ka_c, va_c, qb_c, kb_c, vb_c, qm_c, km_c, vm_c, om_c, gm_c, gl_c = split_columns(hc @ w_in)
    qa = group(apply_rope(heads(qa, A_HEADS), cos, sin), A_KV)
    ka = apply_rope(heads(ka, A_KV), cos, sin)
    va = heads(va, A_KV)
    qa_c, ka_c, va_c = group(heads(qa_c, A_HEADS), A_KV), heads(ka_c, A_KV), heads(va_c, A_KV)
    y_a = windowed_attention(qa, ka, va, ka_c, va_c, attn_sink)
    qn, kn = qk_norm_g[0], qk_norm_g[1]
    qb = group(apply_rope(rms_norm(heads(qb, B_HEADS), qn), cos, sin), B_KV)
    kb = apply_rope(rms_norm(heads(kb, B_KV), kn), cos, sin)
    vb = heads(vb, B_KV)
    qb_c = group(rms_norm(heads(qb_c, B_HEADS), qn), B_KV)
    kb_c, vb_c = rms_norm(heads(kb_c, B_KV), kn), heads(vb_c, B_KV)
    y_b = dense_attention(qb, jnp.concatenate([kb_c, kb], axis=1), jnp.concatenate([vb_c, vb], axis=1))
    y_m, y_m_c = mlstm_mixer((qm, km, vm, om, gm), (qm_c, km_c, vm_c, om_c, gm_c), need_ctx,
                             conv_w, conv_b, gate_b, head_g)
    y = merge(y_a, y_b, y_m, gl, w_branch, w_out)
    if not need_ctx:
        return y, None
    y_a_c = gqa_softmax(qa_c, ka_c, va_c, None, attn_sink)
    y_b_c = gqa_softmax(qb_c, kb_c, vb_c, None, None)
    return y, merge(y_a_c, y_b_c, y_m_c, gl_c, w_branch, w_out)


def setup_inputs(seed: int = 0) -> dict:
    key = jax.random.key(seed)
    ks = jax.random.split(key, 20)
    f32 = jnp.float32

    def nrm(k, shape, scale):
        return jax.random.normal(k, shape, f32) * scale

    L = DEPTH
    i_bias = nrm(ks[15], (L, 2, C_HEADS), 0.1)
    f_bias = jnp.linspace(F_BIAS_LO, F_BIAS_HI, C_HEADS, dtype=f32) + nrm(ks[16], (L, 2, C_HEADS), 0.1)
    return {
        'x': nrm(ks[0], (BATCH, SEQ, D_MODEL), 1.0),
        'c': nrm(ks[1], (BATCH, D_MODEL), 1.0),
        'ctx': nrm(ks[2], (BATCH, CTX_LEN, D_MODEL), 1.0),
        'c_ctx': nrm(ks[3], (D_MODEL,), 1.0),
        'w_ada': nrm(ks[4], (L, D_MODEL, N_MOD * D_MODEL), 0.5 * D_MODEL ** -0.5),
        'b_ada': nrm(ks[5], (L, N_MOD * D_MODEL), 0.01),
        'norm_g': 1.0 + nrm(ks[6], (L, 6, D_MODEL), 0.02),
        'ffn_w_gate': nrm(ks[7], (L, 2, D_MODEL, D_FF), D_MODEL ** -0.5),
        'ffn_w_up': nrm(ks[8], (L, 2, D_MODEL, D_FF), D_MODEL ** -0.5),
        'ffn_w_down': nrm(ks[9], (L, 2, D_FF, D_MODEL), D_FF ** -0.5),
        'w_in': nrm(ks[10], (L, D_MODEL, IN_WIDTH), D_MODEL ** -0.5),
        'attn_sink': nrm(ks[11], (L, A_HEADS), 0.5),
        'qk_norm_g': 1.0 + nrm(ks[12], (L, 2, HEAD_DIM), 0.02),
        'conv_w': nrm(ks[13], (L, C_CONV, 2 * C_WIDTH), C_CONV ** -0.5),
        'conv_b': nrm(ks[14], (L, 2 * C_WIDTH), 0.01),
        'mlstm_gate_b': jnp.stack([i_bias, f_bias], axis=2).reshape(L, 4 * C_HEADS),
        'mlstm_norm_g': 1.0 + nrm(ks[17], (L, C_WIDTH), 0.02),
        'w_branch': nrm(ks[18], (L, N_BRANCH, BRANCH_WIDTH, D_MODEL), BRANCH_WIDTH ** -0.5),
        'w_out': nrm(ks[19], (L, D_MODEL, D_MODEL), D_MODEL ** -0.5),
    }


def reference(x, c, ctx, c_ctx, w_ada, b_ada, norm_g, ffn_w_gate, ffn_w_up, ffn_w_down, w_in, attn_sink,
              qk_norm_g, conv_w, conv_b, mlstm_gate_b, mlstm_norm_g, w_branch, w_out):
    bsz, t_lat = x.shape[:2]
    rows = t_lat // GRID_W
    cos, sin = axial_rope_tables(rows)
    for l in range(DEPTH):
        last = l == DEPTH - 1
        mod = (jax.nn.silu(c) @ w_ada[l] + b_ada[l]).reshape(bsz, 1, N_MOD, D_MODEL)
        mod_c = (jax.nn.silu(c_ctx) @ w_ada[l] + b_ada[l]).reshape(1, 1, N_MOD, D_MODEL)
        ffn1 = (ffn_w_gate[l, 0], ffn_w_up[l, 0], ffn_w_down[l, 0])
        ffn2 = (ffn_w_gate[l, 1], ffn_w_up[l, 1], ffn_w_down[l, 1])
        x = half_ffn(x, mod, 0, norm_g[l], ffn1)
        ctx = half_ffn(ctx, mod_c, 0, norm_g[l], ffn1)
        h = modulated_norm(x, mod, 1, norm_g[l])
        hc = modulated_norm(ctx, mod_c, 1, norm_g[l])
        y, y_c = token_mixers(h, hc, not last, cos, sin, w_in[l], attn_sink[l], qk_norm_g[l], conv_w[l], conv_b[l],
                              mlstm_gate_b[l], mlstm_norm_g[l], w_branch[l], w_out[l])
        x = gated_residual(x, y, mod, 1, norm_g[l], 1.0)
        x = half_ffn(x, mod, 2, norm_g[l], ffn2)
        if not last:
            ctx = gated_residual(ctx, y_c, mod_c, 1, norm_g[l], 1.0)
            ctx = half_ffn(ctx, mod_c, 2, norm_g[l], ffn2)
    return x
```

```cpp
#include <hip/hip_runtime.h>
#include <hip/hip_cooperative_groups.h>
#include <cstdio>
#include <cstdint>
namespace cg = cooperative_groups;

#ifndef MK_MULTI
#define MK_MULTI 0
#endif

#ifndef PROBE_GEMM_REPS
#define PROBE_GEMM_REPS 1
#endif
#ifndef PROBE_SYNC_REPS
#define PROBE_SYNC_REPS 1
#endif
#ifndef PROBE_MIX_REPS
#define PROBE_MIX_REPS 1
#endif
#define LAS __attribute__((address_space(3)))
typedef unsigned short bf16_t;
typedef short bf16x8 __attribute__((ext_vector_type(8)));
typedef short s16x4 __attribute__((ext_vector_type(4)));
typedef float f32x2 __attribute__((ext_vector_type(2)));
typedef float f32x4 __attribute__((ext_vector_type(4)));
typedef float f32x16 __attribute__((ext_vector_type(16)));
typedef unsigned u32x4 __attribute__((ext_vector_type(4)));
typedef unsigned u32x2 __attribute__((ext_vector_type(2)));

constexpr int TL = 32768, TC = 4096, MT = TL + TC, DM = 1024, FF = 2816, NL = 4;
constexpr int SEQ = 2048, CTXL = 256, NB = 16;
constexpr int PA = 3328;
constexpr int GSW = 3584;
constexpr int INW = 6672;
constexpr float EPS = 1e-6f;
constexpr int NPH = 2 + 14 * NL;
constexpr int LDS_BYTES = 147456;

constexpr size_t MiB = 1u << 20;
constexpr size_t WS_CTL = 0;
constexpr size_t WS_BAR = 4096;
constexpr size_t WS_MOD = 4096 + 16384;
constexpr size_t WS_GM = WS_MOD + (size_t)NL * 17 * 9216 * 4;
constexpr size_t WS_W = 8 * MiB;
constexpr size_t WS_XC = 64 * MiB;
constexpr size_t WS_HN = 80 * MiB;
constexpr size_t WS_RG0 = 152 * MiB;
constexpr size_t WS_Y3 = 404 * MiB;
constexpr size_t WS_HFB = 512 * MiB;
constexpr size_t WS_QK = 584 * MiB;
constexpr size_t WS_END = 656 * MiB;
constexpr size_t WS_SCN = WS_END + 24 * MiB;
static_assert(WS_GM + (size_t)MT * 16 * 4 <= WS_W, "ws map");
constexpr size_t W_GU1 = 0, W_D1 = W_GU1 + (size_t)5632 * 1024, W_GU2 = W_D1 + (size_t)1024 * 2816, W_D2 = W_GU2 + (size_t)5632 * 1024;
constexpr size_t W_INA = W_D2 + (size_t)1024 * 2816, W_INB = W_INA + (size_t)PA * 1024, W_B = W_INB + (size_t)GSW * 1024, W_O = W_B + (size_t)3 * 1024 * 512, W_END = W_O + (size_t)1024 * 1024;
static_assert(WS_W + W_END * 2 <= WS_XC, "weights fit");

__device__ __forceinline__ int tidx() { int t = threadIdx.x; asm volatile("" : "+v"(t)); return t; }
__device__ __forceinline__ int bidx() { int t = blockIdx.x; asm volatile("" : "+s"(t)); return t; }
__device__ __forceinline__ float bf2f(unsigned short u) { return __builtin_bit_cast(float, (unsigned)u << 16); }
__device__ __forceinline__ unsigned pk2(float lo, float hi) { unsigned r; asm volatile("v_cvt_pk_bf16_f32 %0, %1, %2" : "=v"(r) : "v"(lo), "v"(hi)); return r; }
__device__ __forceinline__ float wave_sum(float v) {
#pragma unroll
    for (int o = 1; o < 64; o <<= 1) v += __shfl_xor(v, o);
    return v;
}
__device__ __forceinline__ float max3f_(float a, float b, float c) { float r; asm("v_max3_f32 %0, %1, %2, %3" : "=v"(r) : "v"(a), "v"(b), "v"(c)); return r; }
#define LDS_BAR() asm volatile("s_waitcnt lgkmcnt(0)\n\ts_barrier" ::: "memory")
__device__ __forceinline__ float sigmoidf_(float x) { return __builtin_amdgcn_rcpf(1.f + __builtin_amdgcn_exp2f(-1.4426950408889634f * x)); }
__device__ __forceinline__ float siluf_(float x) { return x * __builtin_amdgcn_rcpf(1.f + __builtin_amdgcn_exp2f(-1.4426950408889634f * x)); }
__device__ __forceinline__ void unpack8(u32x4 w, float* f) {
    f[0] = __builtin_bit_cast(float, w.x << 16); f[1] = __builtin_bit_cast(float, w.x & 0xffff0000u);
    f[2] = __builtin_bit_cast(float, w.y << 16); f[3] = __builtin_bit_cast(float, w.y & 0xffff0000u);
    f[4] = __builtin_bit_cast(float, w.z << 16); f[5] = __builtin_bit_cast(float, w.z & 0xffff0000u);
    f[6] = __builtin_bit_cast(float, w.w << 16); f[7] = __builtin_bit_cast(float, w.w & 0xffff0000u);
}
__device__ __forceinline__ u32x4 pack8(const float* f) { u32x4 w; w.x = pk2(f[0], f[1]); w.y = pk2(f[2], f[3]); w.z = pk2(f[4], f[5]); w.w = pk2(f[6], f[7]); return w; }

namespace pg8 {
constexpr int BM = 256, BK = 64, HALF = 128, HTB = HALF * BK * 2, NXCD = 8, WGM = 8;
__host__ __device__ __forceinline__ int lds_byte(int r, int c) { const int st = (r >> 4) * 2 + (c >> 5), rr = r & 15, cc = c & 31, ob = rr * 64 + cc * 2; return st * 1024 + (ob ^ (((ob >> 9) & 1) << 5)); }
__host__ __device__ __forceinline__ void stage_rc(int b, int& R, int& C) { const int st = b / 1024, sb = b % 1024, swz = sb ^ (((sb >> 9) & 1) << 5); R = (st >> 1) * 16 + swz / 64; C = (st & 1) * 32 + (swz % 64) / 2; }
__host__ __device__ __forceinline__ int perm32(int rho) { const int n = rho >> 4, i = rho & 15; return 8 * (i >> 2) + 4 * n + (i & 3); }

struct Unit { int pm, pn, z, k0, nt, part; };
struct Gemm { const bf16_t* A; const bf16_t* Bt; int M, N, K; size_t zA, zB; };

struct Order {
    int nM, nN, nwg, G, c, nz, ktiles, nsplit_tiles;
    __device__ void init(int M, int N, int K, int G_, int c_, int nz_, int split_mtiles) {
        nM = M / BM - split_mtiles; nN = N / BM; nwg = nM * nN; G = G_; c = c_; nz = nz_; ktiles = K / BK; nsplit_tiles = split_mtiles; }
    __device__ bool next(int i, Unit& u) const {
        const int ii = i / nz; u.z = i - ii * nz;
        const long L = (long)ii * G + c;
        u.k0 = 0; u.nt = ktiles; u.part = 0;
        if (L >= nwg) {
            const int q = (int)(L - nwg); if (q >= nsplit_tiles * nN * 4) return false;
            const int kp = q & 3, tile = q >> 2;
            u.pm = nM + tile / nN; u.pn = tile % nN; u.part = kp;
            const int base = (ktiles / 4) & ~1, extra = (ktiles - 4 * base) / 2;
            u.nt = base + (kp < extra ? 2 : 0); u.k0 = kp * base + 2 * (kp < extra ? kp : extra);
            return true;
        }
        int wgid = (int)L; { const int q = nwg / NXCD, r = nwg % NXCD, xcd = wgid % NXCD, off = wgid / NXCD; wgid = (xcd < r ? xcd * (q + 1) : r * (q + 1) + (xcd - r) * q) + off; }
        const int nig = WGM * nN, gid = wgid / nig, fm = gid * WGM, gsz = (nM - fm) < WGM ? (nM - fm) : WGM;
        u.pm = fm + ((wgid % nig) % gsz); u.pn = (wgid % nig) / gsz; return true;
    }
};

struct Epi {
    int MODE; bf16_t* O; int ldc; float* gm; int gm_pn; const bf16_t* GS; const float* qkn; bf16_t* O2;
    __device__ __forceinline__ void operator()(const f32x4 (&acc)[2][2][4][2], const Unit& u, int wr, int wc, int fr, int fq) const {
        const int row0 = u.pm * BM + wr * 64 + fr;
        if (MODE == 1) {
            const int col0 = u.pn * 128 + wc * 32 + 8 * fq;
#pragma unroll
            for (int ai = 0; ai < 2; ++ai)
#pragma unroll
                for (int m = 0; m < 4; ++m) {
                    bf16_t* rowp = O + (size_t)(row0 + ai * HALF + m * 16) * ldc + col0;
                    float v[8];
#pragma unroll
                    for (int n = 0; n < 2; ++n)
#pragma unroll
                        for (int j = 0; j < 4; j += 2) {
                            const f32x2 g = (f32x2){acc[ai][0][m][n][j], acc[ai][0][m][n][j + 1]}, up = (f32x2){acc[ai][1][m][n][j], acc[ai][1][m][n][j + 1]};
                            const f32x2 e = g * (f32x2){-1.4426950408889634f, -1.4426950408889634f};
                            f32x2 d; d.x = __builtin_amdgcn_exp2f(e.x); d.y = __builtin_amdgcn_exp2f(e.y);
                            d = d + (f32x2){1.f, 1.f};
                            f32x2 r; r.x = __builtin_amdgcn_rcpf(d.x); r.y = __builtin_amdgcn_rcpf(d.y);
                            const f32x2 o2 = (g * up) * r;
                            v[4 * n + j] = o2.x; v[4 * n + j + 1] = o2.y;
                        }
                    *(u32x4*)rowp = pack8(v);
                    __builtin_amdgcn_sched_barrier(0);
                }
        } else if (MODE == 0 && gm != nullptr && u.pn < 6 && (wc < 2 || (u.pn != 2 && u.pn != 5))) {
            const int col0 = u.pn * BM + wc * 32 + 8 * fq;
            const int axis = fq >> 1, pb = 8 * (fq & 1);
            const bool isB = u.pn >= 3;
            const float* gn = qkn + ((u.pn == 5) ? 64 : 0) + axis * 32 + pb;
            constexpr float FRQ[8] = {1.f, 0.5623413251903491f, 0.31622776601683794f, 0.17782794100389228f, 0.1f, 0.05623413251903491f, 0.031622776601683794f, 0.017782794100389228f};
            const float fsc = (fq & 1) ? 0.01f : 1.f;
#pragma unroll
            for (int ai = 0; ai < 2; ++ai)
#pragma unroll
                for (int m = 0; m < 4; ++m) {
                    const int row = row0 + ai * HALF + m * 16;
                    float x1[8], x2[8];
#pragma unroll
                    for (int n = 0; n < 2; ++n)
#pragma unroll
                        for (int j = 0; j < 4; ++j) { x1[4 * n + j] = acc[ai][0][m][n][j]; x2[4 * n + j] = acc[ai][1][m][n][j]; }
                    if (isB) {
                        float ss = 0.f;
#pragma unroll
                        for (int e = 0; e < 8; ++e) ss += x1[e] * x1[e] + x2[e] * x2[e];
                        ss += __shfl_xor(ss, 16); ss += __shfl_xor(ss, 32);
                        const float rms = 1.f / sqrtf(ss * (1.f / 64.f) + EPS);
#pragma unroll
                        for (int e = 0; e < 8; ++e) { x1[e] = x1[e] * rms * gn[e]; x2[e] = x2[e] * rms * gn[16 + e]; }
                    }
                    if (row < TL) {
                        const int t = row & (SEQ - 1); const float pos = (float)(axis == 0 ? (t >> 6) : (t & 63)) * fsc;
#pragma unroll
                        for (int e = 0; e < 8; ++e) { const float ang = pos * FRQ[e]; const float c = __cosf(ang), sn = __sinf(ang);
                            const float o1 = x1[e] * c - x2[e] * sn, o2 = x2[e] * c + x1[e] * sn; x1[e] = o1; x2[e] = o2; }
                    }
                    *(u32x4*)(O + (size_t)row * ldc + col0) = pack8(x1);
                    *(u32x4*)(O + (size_t)row * ldc + col0 + HALF) = pack8(x2);
                    __builtin_amdgcn_sched_barrier(0);
                }
        } else {
            const int col0 = u.pn * BM + wc * 32 + 8 * fq;
#pragma unroll
            for (int ai = 0; ai < 2; ++ai)
#pragma unroll
                for (int m = 0; m < 4; ++m) {
                    const int row = row0 + ai * HALF + m * 16;
#pragma unroll
                    for (int bj = 0; bj < 2; ++bj) {
                        const int col = col0 + bj * HALF;
                        float v[8];
#pragma unroll
                        for (int n = 0; n < 2; ++n)
#pragma unroll
                            for (int j = 0; j < 4; ++j) v[4 * n + j] = acc[ai][bj][m][n][j];
                        if (MODE == 0) {
                            bf16_t* dst = u.part == 0 ? O + (size_t)row * ldc + col : O2 + ((size_t)(u.part - 1) * TC + (row - TL)) * 1024 + col;
                            *(u32x4*)dst = pack8(v);
                            if (gm != nullptr && u.pn == gm_pn && bj == 0 && wc == 0 && fq < 2) {
                                float* g = gm + (size_t)row * 16 + 8 * fq;
                                *(f32x4*)g = (f32x4){v[0], v[1], v[2], v[3]}; *(f32x4*)(g + 4) = (f32x4){v[4], v[5], v[6], v[7]};
                            }
                        } else if (MODE == 2) {
#pragma unroll
                            for (int e = 0; e < 8; ++e) v[e] = sigmoidf_(v[e]);
                            *(u32x4*)(O + (size_t)row * ldc + col) = pack8(v);
                        } else {
                            float g[8]; unpack8(*(const u32x4*)(GS + (size_t)row * GSW + 512 + u.z * 1024 + col), g);
                            bf16_t* up = O + (size_t)row * ldc + col;
                            if (u.z == 0) {
#pragma unroll
                                for (int e = 0; e < 8; ++e) v[e] *= g[e];
                            } else {
                                float o[8]; unpack8(*(const u32x4*)up, o);
#pragma unroll
                                for (int e = 0; e < 8; ++e) v[e] = o[e] + v[e] * g[e];
                            }
                            *(u32x4*)up = pack8(v);
                        }
                        __builtin_amdgcn_sched_barrier(0);
                    }
                }
        }
    }
    __device__ __forceinline__ bool merge3(f32x4 (&acc)[2][2][4][2], const Unit& u, int wr, int wc, int fr, int fq) const {
        const int row0 = u.pm * BM + wr * 64 + fr;
            const int col0 = u.pn * BM + wc * 32 + 8 * fq;
#pragma unroll
            for (int ai = 0; ai < 2; ++ai)
#pragma unroll
                for (int m = 0; m < 4; ++m) {
                    const int row = row0 + ai * HALF + m * 16;
                    u32x4 gv[2], hv[2];
#pragma unroll
                    for (int bj = 0; bj < 2; ++bj) {
                        gv[bj] = __builtin_nontemporal_load((const u32x4*)(GS + (size_t)row * GSW + 512 + u.z * 1024 + col0 + bj * HALF));
                        hv[bj] = __builtin_nontemporal_load((const u32x4*)(GS + (size_t)row * GSW + 512 + (u.z < 2 ? u.z + 1 : 2) * 1024 + col0 + bj * HALF));
                    }
#pragma unroll
                    for (int bj = 0; bj < 2; ++bj) {
                        float g[8], h[8]; unpack8(gv[bj], g); unpack8(hv[bj], h);
                        if (u.z < 2) {
#pragma unroll
                            for (int n = 0; n < 2; ++n)
#pragma unroll
                                for (int j = 0; j < 4; ++j) acc[ai][bj][m][n][j] *= g[4 * n + j] * __builtin_amdgcn_rcpf(fmaxf(h[4 * n + j], 1e-30f));
                        } else {
                            float v[8];
#pragma unroll
                            for (int n = 0; n < 2; ++n)
#pragma unroll
                                for (int j = 0; j < 4; ++j) v[4 * n + j] = acc[ai][bj][m][n][j] * g[4 * n + j];
                            *(u32x4*)(O + (size_t)row * ldc + col0 + bj * HALF) = pack8(v);
                        }
                    }
                    __builtin_amdgcn_sched_barrier(0);
                }
        return u.z < 2;
    }
};

template <bool KEEP3, class EpiT>
__device__ __forceinline__ void gemm_phase(LAS unsigned char* lds, const Gemm g, const Order& S, const EpiT& E) {
    const int tid_ = tidx();
    const int tid = tid_, wid = __builtin_amdgcn_readfirstlane(tid >> 6), lane = tid & 63, wr = wid >> 2, wc = wid & 3, fr = lane & 15, fq = lane >> 4;
    const int K = g.K;
    unsigned voffA[2], voffB[2];
#pragma unroll
    for (int i = 0; i < 2; ++i) { int R, C; stage_rc(tid * 16 + i * 8192, R, C); const int Rb = (R & ~31) + perm32(R & 31);
        voffA[i] = (unsigned)(R * K + C) * 2u; voffB[i] = (unsigned)(Rb * K + C) * 2u; }
    const size_t kstep = (size_t)(BK * 2);
    const size_t hstep = (size_t)HALF * K * 2;
    const size_t tstep = 2 * hstep;
    const unsigned ldsw = (unsigned)wid * 1024u;
    const int aoff = lds_byte(wr * 64 + fr, fq * 8), boff = lds_byte(wc * 32 + fr, fq * 8);
#define PG8_SA(b, h) (((b) * 2 + (h)) * HTB)
#define PG8_SB(b, h) ((4 + (b) * 2 + (h)) * HTB)
#define PG8_STAGE(bufoff, gbase, voff) do { _Pragma("unroll") for (int _i = 0; _i < 2; ++_i) \
        __builtin_amdgcn_global_load_lds((const unsigned*)((const char*)(gbase) + (voff)[_i]), (LAS unsigned*)(lds + (bufoff) + ldsw + _i * 8192), 16, 0, 0); } while (0)
#define PG8_LDA(dst, b, h) do { _Pragma("unroll") for (int m = 0; m < 4; ++m) _Pragma("unroll") for (int k = 0; k < 2; ++k) dst[m][k] = *(const LAS bf16x8*)(lds + PG8_SA(b, h) + aoff + m * 2048 + k * 1024); } while (0)
#define PG8_LDB(dst, b, h) do { _Pragma("unroll") for (int n = 0; n < 2; ++n) _Pragma("unroll") for (int k = 0; k < 2; ++k) dst[n][k] = *(const LAS bf16x8*)(lds + PG8_SB(b, h) + boff + n * 2048 + k * 1024); } while (0)
#define PG8_MMA(ai, bj, At, Bt) do { __builtin_amdgcn_s_setprio(1); _Pragma("unroll") for (int m = 0; m < 4; ++m) _Pragma("unroll") for (int n = 0; n < 2; ++n) _Pragma("unroll") for (int k = 0; k < 2; ++k) \
        acc[ai][bj][m][n] = __builtin_amdgcn_mfma_f32_16x16x32_bf16(Bt[n][k], At[m][k], acc[ai][bj][m][n], 0, 0, 0); __builtin_amdgcn_s_setprio(0); } while (0)
#define PG8_WAIT_V(n) asm volatile("s_waitcnt vmcnt(" #n ")" ::: "memory")
#define PG8_WAIT_L(n) asm volatile("s_waitcnt lgkmcnt(" #n ")" ::: "memory")
#define PG8_BAR __builtin_amdgcn_s_barrier()
#define PG8_SCHED __builtin_amdgcn_sched_barrier(0)
    Unit cur, nxt; int ui = 0;
    if (!S.next(0, cur)) return;
    f32x4 acc[2][2][4][2];
#pragma unroll
    for (int a = 0; a < 2; ++a)
#pragma unroll
        for (int b = 0; b < 2; ++b)
#pragma unroll
            for (int m = 0; m < 4; ++m)
#pragma unroll
                for (int n = 0; n < 2; ++n) acc[a][b][m][n] = (f32x4){0.f, 0.f, 0.f, 0.f};
    bf16x8 At[4][2], B0[2][2], B1[2][2];
    const char* cA = (const char*)g.A + (size_t)cur.z * g.zA + (size_t)cur.pm * tstep + (size_t)cur.k0 * kstep; const char* cB = (const char*)g.Bt + (size_t)cur.z * g.zB + (size_t)cur.pn * tstep + (size_t)cur.k0 * kstep;
    PG8_STAGE(PG8_SB(0, 0), cB, voffB); PG8_STAGE(PG8_SB(0, 1), cB + hstep, voffB); PG8_STAGE(PG8_SA(0, 0), cA, voffA); PG8_STAGE(PG8_SA(0, 1), cA + hstep, voffA);
    if (wr == 1) PG8_BAR;
    PG8_WAIT_V(2); PG8_BAR;
    PG8_STAGE(PG8_SB(1, 0), cB + kstep, voffB); PG8_STAGE(PG8_SA(1, 0), cA + kstep, voffA); PG8_STAGE(PG8_SB(1, 1), cB + hstep + kstep, voffB);
    PG8_WAIT_V(6); PG8_BAR;
    for (;;) {
        const bool has_next = S.next(ui + 1, nxt);
        const char* nA = has_next ? (const char*)g.A + (size_t)nxt.z * g.zA + (size_t)nxt.pm * tstep + (size_t)nxt.k0 * kstep : cA; const char* nB = has_next ? (const char*)g.Bt + (size_t)nxt.z * g.zB + (size_t)nxt.pn * tstep + (size_t)nxt.k0 * kstep : cB;
        const int nt = cur.nt;
        for (int t = 0; t < nt; t += 2) {
            const bool last = (t == nt - 2);
            const char* a1 = cA + (size_t)(t + 1) * kstep;
            const char* a2 = last ? nA : cA + (size_t)(t + 2) * kstep; const char* b2 = last ? nB : cB + (size_t)(t + 2) * kstep;
            const char* a3 = a2 + kstep; const char* b3 = b2 + kstep;
            PG8_LDB(B0, 0, 0); PG8_LDB(B1, 0, 1); PG8_SCHED; PG8_LDA(At, 0, 0); PG8_STAGE(PG8_SA(1, 1), a1 + hstep, voffA);
            PG8_WAIT_V(8); PG8_WAIT_L(0); PG8_BAR; PG8_MMA(0, 0, At, B0); PG8_MMA(0, 1, At, B1); PG8_BAR; PG8_SCHED;
            PG8_LDA(At, 0, 1); PG8_STAGE(PG8_SB(0, 0), b2, voffB); PG8_STAGE(PG8_SB(0, 1), b2 + hstep, voffB); PG8_STAGE(PG8_SA(0, 0), a2, voffA);
            PG8_WAIT_V(8); PG8_WAIT_L(0); PG8_BAR; PG8_MMA(1, 0, At, B0); PG8_MMA(1, 1, At, B1); PG8_BAR; PG8_SCHED;
            PG8_LDB(B0, 1, 0); PG8_LDB(B1, 1, 1); PG8_SCHED; PG8_LDA(At, 1, 0); PG8_STAGE(PG8_SA(0, 1), a2 + hstep, voffA);
            PG8_WAIT_V(8); PG8_WAIT_L(0); PG8_BAR; PG8_MMA(0, 0, At, B0); PG8_MMA(0, 1, At, B1); PG8_BAR; PG8_SCHED;
            PG8_LDA(At, 1, 1); PG8_STAGE(PG8_SB(1, 0), b3, voffB); PG8_STAGE(PG8_SB(1, 1), b3 + hstep, voffB); PG8_STAGE(PG8_SA(1, 0), a3, voffA);
            PG8_WAIT_V(8); PG8_WAIT_L(0); PG8_BAR; PG8_MMA(1, 0, At, B0); PG8_MMA(1, 1, At, B1); PG8_BAR; PG8_SCHED;
        }
        if (wr == 0) PG8_BAR;
        bool keep = false;
        if constexpr (KEEP3) keep = E.merge3(acc, cur, wr, wc, fr, fq); else E(acc, cur, wr, wc, fr, fq);
        if (!has_next) break;
        if (!keep) {
#pragma unroll
            for (int a = 0; a < 2; ++a)
#pragma unroll
                for (int b = 0; b < 2; ++b)
#pragma unroll
                    for (int m = 0; m < 4; ++m)
#pragma unroll
                        for (int n = 0; n < 2; ++n) acc[a][b][m][n] = (f32x4){0.f, 0.f, 0.f, 0.f};
        }
        cur = nxt; cA = nA; cB = nB; ++ui;
        if (wr == 1) PG8_BAR;
    }
    PG8_WAIT_V(0);
    PG8_BAR;
#undef PG8_SA
#undef PG8_SB
#undef PG8_STAGE
#undef PG8_LDA
#undef PG8_LDB
#undef PG8_MMA
#undef PG8_WAIT_V
#undef PG8_WAIT_L
#undef PG8_BAR
#undef PG8_SCHED
}
}

struct Args {
    const float* in[19];
    float* out; unsigned char* ws;
    int ph_lo, ph_hi;
};
typedef const __attribute__((address_space(4))) Args& ArgsR;
enum { I_X = 0, I_C, I_CTX, I_CCTX, I_WADA, I_BADA, I_NORMG, I_WG, I_WU, I_WD, I_WIN, I_SINK, I_QKN, I_CONVW, I_CONVB, I_GATEB, I_MNORM, I_WB, I_WO };

__device__ __forceinline__ bf16_t* wdst_row(bf16_t* W, int type, int sub, int n, int& K) {
    switch (type) {
    case 0: K = 1024; return W + (sub ? W_GU2 : W_GU1) + (size_t)((n >> 7) * 256 + (n & 127)) * 1024;
    case 1: K = 1024; return W + (sub ? W_GU2 : W_GU1) + (size_t)((n >> 7) * 256 + 128 + (n & 127)) * 1024;
    case 2: K = 2816; return W + (sub ? W_D2 : W_D1) + (size_t)n * 2816;
    case 3: K = 1024;
        if (n < 1536) {
            const int tb = n >= 768 ? 3 : 0, nn = n >= 768 ? n - 768 : n, d = nn & 63;
            int tile, w, qk = 1;
            if (nn < 512) { const int head = nn >> 6; tile = tb + (head >> 2); w = head & 3; }
            else if (nn < 640) { tile = tb + 2; w = (nn - 512) >> 6; }
            else { tile = tb + 2; w = 2 + ((nn - 640) >> 6); qk = 0; }
            const int sl = qk ? ((d >> 4) & 1) * 32 + (d >> 5) * 16 + (d & 15) : d;
            return W + W_INA + (size_t)(256 * tile + (sl >> 5) * 128 + 32 * w + (sl & 31)) * 1024;
        }
        if (n < 3072) return W + W_INA + (size_t)n * 1024;
        if (n < 3584) return W + W_INB + (size_t)(n - 3072) * 1024;
        if (n < 3600) return W + W_INA + (size_t)(3072 + n - 3584) * 1024;
        return W + W_INB + (size_t)(512 + n - 3600) * 1024;
    case 4: K = 512; return W + W_B + (size_t)sub * 1024 * 512 + (size_t)n * 512;
    default: K = 1024; return W + W_O + (size_t)n * 1024;
    }
}
__device__ void convert_weights(ArgsR a, int l, LAS unsigned char* lds, int lo1, int hi1, int lo2, int hi2, int wk, int nwk, int do_pad) {
    LAS float* s = (LAS float*)lds;
    bf16_t* W = (bf16_t*)(a.ws + WS_W);
    const int tid = tidx();
    constexpr int NT_FF = 16 * 44, NT_IN = 16 * 105, NT_B = 8 * 16, NT_O = 16 * 16;
    constexpr int NITEMS = 6 * NT_FF + NT_IN + 3 * NT_B + NT_O;
    const int n1 = hi1 - lo1, ntot = n1 + (hi2 - lo2);
    for (int ii = wk; ii < ntot; ii += nwk) {
        const int it = ii < n1 ? lo1 + ii : lo2 + (ii - n1);
        int r = it, type, sub = 0, K, N; const float* src;
        if (r < 4 * NT_FF) { const int q = r / NT_FF; r -= q * NT_FF; type = q & 1; sub = q >> 1; K = 1024; N = 2816;
            src = (type == 0 ? a.in[I_WG] : a.in[I_WU]) + ((size_t)l * 2 + sub) * 1024 * 2816; }
        else if ((r -= 4 * NT_FF) < 2 * NT_FF) { sub = r / NT_FF; r -= sub * NT_FF; type = 2; K = 2816; N = 1024; src = a.in[I_WD] + ((size_t)l * 2 + sub) * 2816 * 1024; }
        else if ((r -= 2 * NT_FF) < NT_IN) { type = 3; K = 1024; N = INW; src = a.in[I_WIN] + (size_t)l * 1024 * INW; }
        else if ((r -= NT_IN) < 3 * NT_B) { sub = r / NT_B; r -= sub * NT_B; type = 4; K = 512; N = 1024; src = a.in[I_WB] + ((size_t)l * 3 + sub) * 512 * 1024; }
        else { r -= 3 * NT_B; type = 5; K = 1024; N = 1024; src = a.in[I_WO] + (size_t)l * 1024 * 1024; }
        const int nkb = K / 64, nb = r / nkb, kb = r - nb * nkb, k0 = kb * 64, n0 = nb * 64;
        __syncthreads();
#pragma unroll
        for (int i = 0; i < 8; ++i) { const int kk = i * 8 + (tid >> 6), nn = tid & 63; s[kk * 65 + nn] = (n0 + nn < N) ? __builtin_nontemporal_load(src + (size_t)(k0 + kk) * N + n0 + nn) : 0.f; }
        __syncthreads();
        const int n = tid >> 3, c = tid & 7;
        if (n0 + n < N) {
            int Kd; bf16_t* d = wdst_row(W, type, sub, n0 + n, Kd);
            float v[8];
#pragma unroll
            for (int i = 0; i < 8; ++i) v[i] = s[(8 * c + i) * 65 + n];
            *(u32x4*)(d + k0 + 8 * c) = pack8(v);
        }
    }
    if (do_pad) for (int i = wk * 512 + tid; i < (PA - 3088) * 1024 / 8; i += nwk * 512) *(u32x4*)(W + W_INA + (size_t)3088 * 1024 + (size_t)i * 8) = (u32x4){0u, 0u, 0u, 0u};
    __syncthreads();
}

__device__ void compute_mod(ArgsR a, LAS unsigned char* lds) {
    LAS float* sc = (LAS float*)lds;
    LAS float* red = (LAS float*)(lds + 17 * 1024 * 4);
    const int tid = tidx(), lane = tid & 63, w = tid >> 6;
    float* MOD = (float*)(a.ws + WS_MOD);
    constexpr int NITEMS = NL * 144;
    if ((int)bidx() >= NITEMS) return;
    __syncthreads();
    for (int i = tid; i < 17 * 1024; i += 512) { const int r = i >> 10, k = i & 1023; const float v = r < 16 ? a.in[I_C][r * 1024 + k] : a.in[I_CCTX][k]; sc[i] = siluf_(v); }
    __syncthreads();
    for (int it = bidx(); it < NITEMS; it += gridDim.x) {
        const int l = it / 144, j0 = (it - l * 144) * 64;
        const float* wp = a.in[I_WADA] + (size_t)l * 1024 * 9216 + (size_t)(w * 128) * 9216 + j0 + lane;
        float acc[17];
#pragma unroll
        for (int r = 0; r < 17; ++r) acc[r] = 0.f;
        for (int k8 = 0; k8 < 128; k8 += 16) {
            float wv[16];
#pragma unroll
            for (int u = 0; u < 16; ++u) wv[u] = __builtin_nontemporal_load(wp + (size_t)(k8 + u) * 9216);
#pragma unroll
            for (int u = 0; u < 16; ++u)
#pragma unroll
                for (int r = 0; r < 17; ++r) acc[r] += sc[r * 1024 + w * 128 + k8 + u] * wv[u];
        }
#pragma unroll
        for (int r = 0; r < 17; ++r) red[(w * 17 + r) * 64 + lane] = acc[r];
        __syncthreads();
        for (int i = tid; i < 17 * 64; i += 512) { const int r = i >> 6, col = i & 63; float sacc = a.in[I_BADA][l * 9216 + j0 + col];
#pragma unroll
            for (int ww = 0; ww < 8; ++ww) sacc += red[(ww * 17 + r) * 64 + col];
            MOD[((size_t)l * 17 + r) * 9216 + j0 + col] = sacc; }
        __syncthreads();
    }
}

struct RowP { int init, has_res, has_next, l, kpost, lnext, knext; float w; int nrows; int ksplit; };
__device__ void row_phase(ArgsR a, const RowP p) {
    const int tid = tidx(), lane = tid & 63, w = tid >> 6;
    const int gw = bidx() * 8 + w, NGW = gridDim.x * 8;
    const float* MOD = (const float*)(a.ws + WS_MOD);
    float* xc = (float*)(a.ws + WS_XC);
    bf16_t* HN = (bf16_t*)(a.ws + WS_HN);
    const bf16_t* YB = (const bf16_t*)(a.ws + WS_QK);
    const float* ng = a.in[I_NORMG];
    const int NR = p.nrows, rpw = (NR + NGW - 1) / NGW, m0 = gw * rpw, m1 = (m0 + rpw < NR) ? m0 + rpw : NR;
    if (m0 >= m1) return;
    f32x4 gpost[4], gpre[4], gate[4], sh[4], scl[4];
#pragma unroll
    for (int j = 0; j < 4; ++j) {
        gpost[j] = p.has_res ? *(const f32x4*)(ng + ((size_t)p.l * 6 + 2 * p.kpost + 1) * 1024 + 4 * lane + 256 * j) : (f32x4){0.f, 0.f, 0.f, 0.f};
        gpre[j] = p.has_next ? *(const f32x4*)(ng + ((size_t)p.lnext * 6 + 2 * p.knext) * 1024 + 4 * lane + 256 * j) : (f32x4){0.f, 0.f, 0.f, 0.f};
        gate[j] = sh[j] = scl[j] = (f32x4){0.f, 0.f, 0.f, 0.f};
    }
    int r_cur = -1;
#define RP_XR(m) (p.init ? ((m) < TL ? a.in[I_X] + (size_t)(m) * 1024 : a.in[I_CTX] + (size_t)((m) - TL) * 1024) : ((m) < TL ? a.out + (size_t)(m) * 1024 : xc + (size_t)((m) - TL) * 1024))
    f32x4 vn[4]; u32x2 yn[4], yp[3][4];
#define RP_PART(m, pp, j) (__builtin_nontemporal_load((const u32x2*)((const bf16_t*)(a.ws + WS_END) + ((size_t)(pp) * TC + ((m) - TL)) * 1024 + 4 * lane + 256 * (j))))
#pragma unroll
    for (int pp = 0; pp < 3; ++pp)
#pragma unroll
        for (int j = 0; j < 4; ++j) yp[pp][j] = (u32x2){0u, 0u};
    {
        const float* xr = RP_XR(m0);
#pragma unroll
        for (int j = 0; j < 4; ++j) { vn[j] = __builtin_nontemporal_load((const f32x4*)(xr + 4 * lane + 256 * j)); yn[j] = p.has_res ? __builtin_nontemporal_load((const u32x2*)(YB + (size_t)m0 * 1024 + 4 * lane + 256 * j)) : (u32x2){0u, 0u}; }
        if (p.ksplit && m0 >= TL) {
#pragma unroll
            for (int pp = 0; pp < 3; ++pp)
#pragma unroll
                for (int j = 0; j < 4; ++j) yp[pp][j] = RP_PART(m0, pp, j);
        }
    }
    for (int m = m0; m < m1; ++m) {
        f32x4 v[4]; u32x2 yq[4], yq2[3][4];
#pragma unroll
        for (int j = 0; j < 4; ++j) { v[j] = vn[j]; yq[j] = yn[j]; yq2[0][j] = yp[0][j]; yq2[1][j] = yp[1][j]; yq2[2][j] = yp[2][j]; }
        if (m + 1 < m1) {
            const float* xr = RP_XR(m + 1);
#pragma unroll
            for (int j = 0; j < 4; ++j) { vn[j] = __builtin_nontemporal_load((const f32x4*)(xr + 4 * lane + 256 * j)); if (p.has_res) yn[j] = __builtin_nontemporal_load((const u32x2*)(YB + (size_t)(m + 1) * 1024 + 4 * lane + 256 * j)); }
            if (p.ksplit && m + 1 >= TL) {
#pragma unroll
                for (int pp = 0; pp < 3; ++pp)
#pragma unroll
                    for (int j = 0; j < 4; ++j) yp[pp][j] = RP_PART(m + 1, pp, j);
            }
        }
        const int r = m < TL ? (m >> 11) : 16;
        if (r != r_cur) {
            r_cur = r;
#pragma unroll
            for (int j = 0; j < 4; ++j) {
                if (p.has_res) gate[j] = *(const f32x4*)(MOD + (((size_t)p.l * 17 + r) * 9 + 3 * p.kpost + 2) * 1024 + 4 * lane + 256 * j) * p.w;
                if (p.has_next) { sh[j] = *(const f32x4*)(MOD + (((size_t)p.lnext * 17 + r) * 9 + 3 * p.knext) * 1024 + 4 * lane + 256 * j);
                    scl[j] = *(const f32x4*)(MOD + (((size_t)p.lnext * 17 + r) * 9 + 3 * p.knext + 1) * 1024 + 4 * lane + 256 * j) + 1.f; }
            }
        }
        float* xw = m < TL ? a.out + (size_t)m * 1024 : xc + (size_t)(m - TL) * 1024;
        if (p.has_res) {
            f32x4 y[4]; float ss = 0.f;
#pragma unroll
            for (int j = 0; j < 4; ++j) { const u32x2 q = yq[j];
                y[j] = (f32x4){__builtin_bit_cast(float, q.x << 16), __builtin_bit_cast(float, q.x & 0xffff0000u), __builtin_bit_cast(float, q.y << 16), __builtin_bit_cast(float, q.y & 0xffff0000u)};
                if (p.ksplit && m >= TL) {
#pragma unroll
                    for (int pp = 0; pp < 3; ++pp) { const u32x2 q2 = yq2[pp][j];
                        y[j] = y[j] + (f32x4){__builtin_bit_cast(float, q2.x << 16), __builtin_bit_cast(float, q2.x & 0xffff0000u), __builtin_bit_cast(float, q2.y << 16), __builtin_bit_cast(float, q2.y & 0xffff0000u)}; }
                }
                ss += (y[j].x * y[j].x + y[j].y * y[j].y) + (y[j].z * y[j].z + y[j].w * y[j].w); }
            const float rms = 1.f / sqrtf(wave_sum(ss) * (1.f / 1024.f) + EPS);
#pragma unroll
            for (int j = 0; j < 4; ++j) v[j] = v[j] + gate[j] * ((y[j] * rms) * gpost[j]);
        }
        if (p.has_res) {
#pragma unroll
            for (int j = 0; j < 4; ++j) __builtin_nontemporal_store(v[j], (f32x4*)(xw + 4 * lane + 256 * j));
        }
        if (p.has_next) {
            float ss = 0.f;
#pragma unroll
            for (int j = 0; j < 4; ++j) ss += (v[j].x * v[j].x + v[j].y * v[j].y) + (v[j].z * v[j].z + v[j].w * v[j].w);
            const float rms = 1.f / sqrtf(wave_sum(ss) * (1.f / 1024.f) + EPS);
#pragma unroll
            for (int j = 0; j < 4; ++j) { const f32x4 h = ((v[j] * rms) * gpre[j]) * scl[j] + sh[j];
                u32x2 o; o.x = pk2(h.x, h.y); o.y = pk2(h.z, h.w);
                *(u32x2*)(HN + (size_t)m * 1024 + 4 * lane + 256 * j) = o; }
        }
    }
#undef RP_XR
#undef RP_PART
}

__device__ void prep_phase(ArgsR a, int l, int parts) {
    bf16_t* P = (bf16_t*)(a.ws + WS_RG0);
    bf16_t* QK = (bf16_t*)(a.ws + WS_QK);
    const int gt = bidx() * 512 + tidx(), NT = gridDim.x * 512;
    const float* qkn = a.in[I_QKN] + l * 128;
    if (parts & 1) for (long i = gt; i < (long)MT * 160; i += NT) {
        const int row = (int)(i / 160), rem = (int)(i - (long)row * 160), hs = rem >> 3, j = rem & 7;
        int col; const float* gn = nullptr;
        if (hs < 8) col = 64 * hs; else if (hs < 10) col = 512 + 64 * (hs - 8); else if (hs < 18) { col = 768 + 64 * (hs - 10); gn = qkn; } else { col = 1280 + 64 * (hs - 18); gn = qkn + 64; }
        const int axis = j >> 2, p0 = (j & 3) * 4;
        bf16_t* base = P + (size_t)row * PA + col + axis * 32 + p0;
        const u32x2 r1 = *(const u32x2*)base, r2 = *(const u32x2*)(base + 16);
        float x1[4] = {__builtin_bit_cast(float, r1.x << 16), __builtin_bit_cast(float, r1.x & 0xffff0000u), __builtin_bit_cast(float, r1.y << 16), __builtin_bit_cast(float, r1.y & 0xffff0000u)};
        float x2[4] = {__builtin_bit_cast(float, r2.x << 16), __builtin_bit_cast(float, r2.x & 0xffff0000u), __builtin_bit_cast(float, r2.y << 16), __builtin_bit_cast(float, r2.y & 0xffff0000u)};
        if (gn) {
            float ss = 0.f;
#pragma unroll
            for (int e = 0; e < 4; ++e) ss += x1[e] * x1[e] + x2[e] * x2[e];
            ss += __shfl_xor(ss, 1); ss += __shfl_xor(ss, 2); ss += __shfl_xor(ss, 4);
            const float rms = 1.f / sqrtf(ss * (1.f / 64.f) + EPS);
#pragma unroll
            for (int e = 0; e < 4; ++e) { x1[e] = x1[e] * rms * gn[axis * 32 + p0 + e]; x2[e] = x2[e] * rms * gn[axis * 32 + 16 + p0 + e]; }
        }
        if (row < TL) {
            const int t = row & (SEQ - 1); const float pos = (float)(axis == 0 ? (t >> 6) : (t & 63));
#pragma unroll
            for (int e = 0; e < 4; ++e) {
                const float freq = exp2f(-(float)(p0 + e) * (13.287712379549449f / 16.f));
                const float ang = pos * freq; const float c = __cosf(ang), s = __sinf(ang);
                const float o1 = x1[e] * c - x2[e] * s, o2 = x2[e] * c + x1[e] * s; x1[e] = o1; x2[e] = o2;
            }
        }
        if (gn || row < TL) {
            u32x2 o1, o2; o1.x = pk2(x1[0], x1[1]); o1.y = pk2(x1[2], x1[3]); o2.x = pk2(x2[0], x2[1]); o2.y = pk2(x2[2], x2[3]);
            *(u32x2*)base = o1; *(u32x2*)(base + 16) = o2;
        }
    }
    if (parts & 2) {
        const float* cw = a.in[I_CONVW] + (size_t)l * 5 * 1024; const float* cb = a.in[I_CONVB] + (size_t)l * 1024;
        const int oct = gt & 127, run = gt >> 7, nruns = NT >> 7, c0 = oct * 8;
        const int rpr = (MT + nruns - 1) / nruns;
        const int r0 = run * rpr, r1 = (r0 + rpr < MT) ? r0 + rpr : MT;
        float wt[5][8], bs[8];
#pragma unroll
        for (int j = 0; j < 5; ++j)
#pragma unroll
            for (int e = 0; e < 8; ++e) wt[j][e] = cw[j * 1024 + c0 + e];
#pragma unroll
        for (int e = 0; e < 8; ++e) bs[e] = cb[c0 + e];
        const float scl = c0 < 512 ? 0.08838834764831845f : 1.f;
#define CV_LD(rr) (((rr) >= 0 && (rr) < MT) ? *(const u32x4*)(P + (size_t)(rr) * PA + 1536 + c0) : (u32x4){0u, 0u, 0u, 0u})
        if (r0 < r1) {
            u32x4 win[8], nxt[4];
#pragma unroll
            for (int j = 0; j < 8; ++j) win[j] = CV_LD(r0 - 2 + j);
            for (int base = r0; base < r1; base += 4) {
#pragma unroll
                for (int j = 0; j < 4; ++j) nxt[j] = CV_LD(base + 6 + j);
#pragma unroll
                for (int q = 0; q < 4; ++q) {
                    const int row = base + q;
                    if (row < r1) {
                        int t, len; if (row < TL) { t = row & (SEQ - 1); len = SEQ; } else { t = (row - TL) & (CTXL - 1); len = CTXL; }
                        float acc[8];
#pragma unroll
                        for (int e = 0; e < 8; ++e) acc[e] = bs[e];
#pragma unroll
                        for (int j = 0; j < 5; ++j) {
                            const int tt = t + j - 2;
                            if (tt >= 0 && tt < len) {
                                float x[8]; unpack8(win[q + j], x);
#pragma unroll
                                for (int e = 0; e < 8; ++e) acc[e] += wt[j][e] * x[e];
                            }
                        }
#pragma unroll
                        for (int e = 0; e < 8; ++e) acc[e] = siluf_(acc[e]) * scl;
                        *(u32x4*)(QK + (size_t)row * 1024 + c0) = pack8(acc);
                    }
                }
#pragma unroll
                for (int j = 0; j < 4; ++j) { win[j] = win[j + 4]; win[j + 4] = nxt[j]; }
            }
        }
#undef CV_LD
    }
    if (parts & 2) {
        const float* GM = (const float*)(a.ws + WS_GM);
        f32x4* SCN = (f32x4*)(a.ws + WS_SCN);
        const int lane = threadIdx.x & 63, gw = gt >> 6, NGW = NT >> 6;
        for (int it = gw; it < (MT / 64) * 8; it += NGW) {
            const int ch = it >> 3, dh = it & 7, dir = dh >> 2, h = dh & 3;
            const int row = ch * 64 + (dir == 0 ? lane : 63 - lane);
            const float iv = GM[(size_t)row * 16 + dir * 8 + h] + a.in[I_GATEB][l * 16 + dir * 8 + h];
            const float fv = GM[(size_t)row * 16 + dir * 8 + 4 + h] + a.in[I_GATEB][l * 16 + dir * 8 + 4 + h];
            const float lf = fminf(fv, 0.f) - log1pf(__expf(-fabsf(fv)));
            float bc = lf;
#pragma unroll
            for (int o2 = 1; o2 < 64; o2 <<= 1) { const float t = __shfl_up(bc, o2); if (lane >= o2) bc += t; }
            const float av = iv - bc;
            float pm = av;
#pragma unroll
            for (int o2 = 1; o2 < 64; o2 <<= 1) { const float t = __shfl_up(pm, o2); if (lane >= o2) pm = fmaxf(pm, t); }
            SCN[(size_t)row * 8 + dh] = (f32x4){av, pm, bc, 0.f};
        }
    }
}

__device__ __forceinline__ void attn_tile(LAS unsigned char* lds, const unsigned cb, const unsigned kf_off, const unsigned vf_off, const bf16x8 (&qf)[4], f32x16 (&o)[2], float& m_run, float& l_run,
                                          const int typeA, const int ti, const int jlo, const int tq, const int hh) {
    const float C2 = 0.125f * 1.4426950408889634f;
    f32x16 st[4];
    {
        bf16x8 kf[4][4];
#pragma unroll
        for (int ks = 0; ks < 4; ++ks)
#pragma unroll
            for (int kt = 0; kt < 4; ++kt) kf[ks][kt] = *(const LAS bf16x8*)(lds + cb + kf_off + kt * (32 * 144) + ks * 32);
#pragma unroll
        for (int kt = 0; kt < 4; ++kt)
#pragma unroll
            for (int e = 0; e < 16; ++e) st[kt][e] = 0.f;
        __builtin_amdgcn_sched_barrier(0);
#pragma unroll
        for (int ks = 0; ks < 4; ++ks)
#pragma unroll
            for (int kt = 0; kt < 4; ++kt) st[kt] = __builtin_amdgcn_mfma_f32_32x32x16_bf16(kf[ks][kt], qf[ks], st[kt], 0, 0, 0);
    }
    s16x4 vfa[4][2][2], vfb[4][2][2];
#pragma unroll
    for (int kt = 0; kt < 4; ++kt)
#pragma unroll
        for (int s2 = 0; s2 < 2; ++s2)
#pragma unroll
            for (int dt = 0; dt < 2; ++dt) {
                const unsigned va = (cb ? 24576u : 0u) + vf_off + (unsigned)((32 * kt + 16 * s2) * 192 + dt * 64);
                vfa[kt][s2][dt] = __builtin_bit_cast(s16x4, __builtin_amdgcn_ds_read_tr16_b64_v4i16((LAS s16x4*)(lds + va)));
                vfb[kt][s2][dt] = __builtin_bit_cast(s16x4, __builtin_amdgcn_ds_read_tr16_b64_v4i16((LAS s16x4*)(lds + va + 8 * 192)));
            }
    __builtin_amdgcn_sched_barrier(0);
    if (typeA && ti >= 2) {
        const int s0 = 128 * (jlo + ti - 2);
#pragma unroll
        for (int kt = 0; kt < 4; ++kt)
#pragma unroll
            for (int e = 0; e < 16; ++e) { const int s = s0 + 32 * kt + (e & 3) + 8 * (e >> 2) + 4 * hh; const int d = tq - s; if (d > 128 || d < -128) st[kt][e] = -INFINITY; }
    }
    float mx0 = fmaxf(st[0][0], st[1][0]), mx1 = fmaxf(st[2][0], st[3][0]);
#pragma unroll
    for (int e = 1; e < 16; ++e) { mx0 = max3f_(mx0, st[0][e], st[1][e]); mx1 = max3f_(mx1, st[2][e], st[3][e]); }
    float mx = fmaxf(mx0, mx1);
    { const auto rr = __builtin_amdgcn_permlane32_swap(__builtin_bit_cast(unsigned, mx), __builtin_bit_cast(unsigned, mx), false, false);
      mx = fmaxf(__builtin_bit_cast(float, rr[0]), __builtin_bit_cast(float, rr[1])); }
    const float m_new = fmaxf(m_run, mx * C2);
    const float alpha = __builtin_amdgcn_exp2f(m_run - m_new);
    m_run = m_new;
    f32x2 psa = (f32x2){0.f, 0.f}, psb = (f32x2){0.f, 0.f};
    const f32x2 c2v = (f32x2){C2, C2}, mnv = (f32x2){m_new, m_new};
#pragma unroll
    for (int kt = 0; kt < 4; kt += 2)
#pragma unroll
        for (int e = 0; e < 16; e += 2) {
            f32x2 va = (f32x2){st[kt][e], st[kt][e + 1]}, vb = (f32x2){st[kt + 1][e], st[kt + 1][e + 1]};
            va = va * c2v - mnv; vb = vb * c2v - mnv;
            va.x = __builtin_amdgcn_exp2f(va.x); va.y = __builtin_amdgcn_exp2f(va.y); vb.x = __builtin_amdgcn_exp2f(vb.x); vb.y = __builtin_amdgcn_exp2f(vb.y);
            psa += va; psb += vb;
            st[kt][e] = va.x; st[kt][e + 1] = va.y; st[kt + 1][e] = vb.x; st[kt + 1][e + 1] = vb.y;
        }
    const float ps0 = psa.x + psa.y, ps1 = psb.x + psb.y;
    l_run = l_run * alpha + (ps0 + ps1);
#pragma unroll
    for (int e = 0; e < 16; ++e) { o[0][e] *= alpha; o[1][e] *= alpha; }
#pragma unroll
    for (int kt = 0; kt < 4; ++kt)
#pragma unroll
        for (int s2 = 0; s2 < 2; ++s2) {
            u32x4 pw; pw.x = pk2(st[kt][8 * s2 + 0], st[kt][8 * s2 + 1]); pw.y = pk2(st[kt][8 * s2 + 2], st[kt][8 * s2 + 3]);
            pw.z = pk2(st[kt][8 * s2 + 4], st[kt][8 * s2 + 5]); pw.w = pk2(st[kt][8 * s2 + 6], st[kt][8 * s2 + 7]);
            const bf16x8 pf = __builtin_bit_cast(bf16x8, pw);
#pragma unroll
            for (int dt = 0; dt < 2; ++dt) {
                const s16x4 v0 = vfa[kt][s2][dt], v1 = vfb[kt][s2][dt];
                const bf16x8 vf = (bf16x8){v0[0], v0[1], v0[2], v0[3], v1[0], v1[1], v1[2], v1[3]};
                o[dt] = __builtin_amdgcn_mfma_f32_32x32x16_bf16(vf, pf, o[dt], 0, 0, 0);
            }
        }
}

__device__ void attn_unit(ArgsR a, int l, LAS unsigned char* lds, int typeA, int b, int kv, int qb, int isctx) {
    const bf16_t* P = (const bf16_t*)(a.ws + WS_RG0);
    bf16_t* Y = (bf16_t*)(a.ws + WS_Y3) + (typeA ? 0 : (size_t)MT * 512);
    const int tid_ = tidx();
    const int tid = tid_, lane = tid & 63, w = __builtin_amdgcn_readfirstlane(tid >> 6), r = lane & 31, hh = lane >> 5;
    const int tb256 = typeA ? 0 : 768;
    const int kcol = tb256 + 512 + 32 * kv, vcol = tb256 + 512 + 32 * (2 + kv);
    const int g = w >> 1, half = w & 1, head = kv * 4 + g;
    const int qrow0 = isctx ? TL + b * CTXL + qb * 64 : b * SEQ + qb * 64;
    const int qrow = qrow0 + 32 * half + r;
    const int tq = qb * 64 + 32 * half + r;
    bf16x8 qf[4];
#pragma unroll
    for (int ks = 0; ks < 4; ++ks) { const int c = 2 * ks + hh; qf[ks] = *(const bf16x8*)(P + (size_t)qrow * PA + tb256 + 256 * (head >> 2) + 32 * (head & 3) + (c >> 2) * 128 + (c & 3) * 8); }
    int jlo = 0, nlat = 0;
    if (!isctx) { if (typeA) { const int t0 = qb * 64; jlo = (t0 - 128) < 0 ? 0 : (t0 - 128) >> 7; int jhi = (t0 + 191) >> 7; if (jhi > 15) jhi = 15; nlat = jhi - jlo + 1; } else { jlo = 0; nlat = 16; } }
    const int ntiles = 2 + nlat;
    const float C2 = 0.125f * 1.4426950408889634f;
    f32x16 o[2];
#pragma unroll
    for (int e = 0; e < 16; ++e) { o[0][e] = 0.f; o[1][e] = 0.f; }
    float m_run = -INFINITY, l_run = 0.f;
    const int srow = tid >> 3, sch = tid & 7, scol = (sch >> 2) * 128 + (sch & 3) * 8;
    const unsigned st_off = (unsigned)(srow * 72 + sch * 8) * 2u;
    const int i16 = lane & 15, g16 = (lane >> 4) & 1;
    const unsigned kf_off = (unsigned)(r * 72 + 8 * hh) * 2u;
    const unsigned vf_off = 36864u + (unsigned)((4 * hh + (i16 >> 2)) * 96 + 16 * g16 + 4 * (i16 & 3)) * 2u;
    const unsigned sv_off = (unsigned)(srow * 96 + sch * 8) * 2u;
#define AT_BASE(t) ((t) < 2 ? TL + b * CTXL + 128 * (t) : b * SEQ + 128 * (jlo + (t) - 2))
#define AT_LOAD(t, kreg, vreg) do { const int _kb = AT_BASE(t); \
        kreg[0] = *(const u32x4*)(P + (size_t)(_kb + srow) * PA + kcol + scol); kreg[1] = *(const u32x4*)(P + (size_t)(_kb + 64 + srow) * PA + kcol + scol); \
        vreg[0] = *(const u32x4*)(P + (size_t)(_kb + srow) * PA + vcol + scol); vreg[1] = *(const u32x4*)(P + (size_t)(_kb + 64 + srow) * PA + vcol + scol); } while (0)
#define AT_STORE(bo, kreg, vreg) do { *(LAS u32x4*)(lds + (bo) + st_off) = kreg[0]; *(LAS u32x4*)(lds + (bo) + 9216 + st_off) = kreg[1]; \
        *(LAS u32x4*)(lds + 36864 + ((bo) ? 24576u : 0u) + sv_off) = vreg[0]; *(LAS u32x4*)(lds + 36864 + ((bo) ? 24576u : 0u) + 12288 + sv_off) = vreg[1]; } while (0)
    u32x4 kr0[2], vr0[2], kr1[2], vr1[2];
    AT_LOAD(0, kr0, vr0);
    __syncthreads();
    AT_STORE(0u, kr0, vr0);
    AT_LOAD(1, kr1, vr1);
    { const int tn = 2 < ntiles ? 2 : ntiles - 1; AT_LOAD(tn, kr0, vr0); }
    LDS_BAR();
    for (int ti = 0; ti < ntiles; ti += 2) {
        attn_tile(lds, 0u, kf_off, vf_off, qf, o, m_run, l_run, typeA, ti, jlo, tq, hh);
        AT_STORE(18432u, kr1, vr1);
        { const int tn = ti + 3 < ntiles ? ti + 3 : ntiles - 1; AT_LOAD(tn, kr1, vr1); }
        LDS_BAR();
        if (ti + 1 < ntiles) attn_tile(lds, 18432u, kf_off, vf_off, qf, o, m_run, l_run, typeA, ti + 1, jlo, tq, hh);
        AT_STORE(0u, kr0, vr0);
        { const int tn = ti + 4 < ntiles ? ti + 4 : ntiles - 1; AT_LOAD(tn, kr0, vr0); }
        LDS_BAR();
    }
#undef AT_BASE
#undef AT_LOAD
#undef AT_STORE
    float lt = l_run + __shfl_xor(l_run, 32);
    if (typeA) lt += exp2f(a.in[I_SINK][l * 8 + head] * 1.4426950408889634f - m_run);
    const float inv = 1.f / lt;
    bf16_t* yr = Y + (size_t)qrow * 512 + head * 64;
#pragma unroll
    for (int dt = 0; dt < 2; ++dt)
#pragma unroll
        for (int rg = 0; rg < 4; ++rg) {
            u32x2 ow; ow.x = pk2(o[dt][4 * rg] * inv, o[dt][4 * rg + 1] * inv); ow.y = pk2(o[dt][4 * rg + 2] * inv, o[dt][4 * rg + 3] * inv);
            *(u32x2*)(yr + 32 * dt + 8 * rg + 4 * hh) = ow;
        }
}

constexpr int ML_QS = 0, ML_KS = 17408, ML_KWT = 34816, ML_VT = 53248, ML_CBT = 73984, ML_SS = 113152, ML_GA = 122368, ML_DEN = 124416;
__device__ void mlstm_unit(ArgsR a, int l, LAS unsigned char* lds, int b, int h, int dir) {
    const bf16_t* P = (const bf16_t*)(a.ws + WS_RG0);
    const bf16_t* QK = (const bf16_t*)(a.ws + WS_QK);
    const f32x4* SCN = (const f32x4*)(a.ws + WS_SCN);
    bf16_t* HF = (bf16_t*)(a.ws + WS_HFB) + (size_t)dir * MT * 512;
    const int tid_ = tidx();
    const int tid = tid_, lane = tid & 63, w = __builtin_amdgcn_readfirstlane(tid >> 6), fr = lane & 15, fq = lane >> 4;
    __syncthreads();
    for (int i = tid; i < 39168 / 4; i += 512) ((LAS unsigned*)(lds + ML_CBT))[i] = 0u;
    for (int i = tid; i < 16 * 72; i += 512) { const int rr = i / 72, cc = i - rr * 72; ((LAS bf16_t*)(lds + ML_VT))[(128 + rr) * 72 + cc] = (rr == 0 && cc < 64) ? (bf16_t)0x3F80 : (bf16_t)0; }
    f32x4 accC[9];
#pragma unroll
    for (int v = 0; v < 9; ++v) accC[v] = (f32x4){0.f, 0.f, 0.f, 0.f};
    float m = 0.f;
    u32x4 qr[2], kr[2], vr[2]; f32x4 scn;
#define ML_ROWBASE(ci) ((ci) < 4 ? TL + b * CTXL + (dir == 0 ? (ci) : 3 - (ci)) * 64 : b * SEQ + (dir == 0 ? (ci) - 4 : 35 - (ci)) * 64)
#define ML_LOAD(ci) do { const int _row = ML_ROWBASE(ci) + (dir == 0 ? lane : 63 - lane); \
        _Pragma("unroll") for (int _o = 0; _o < 2; ++_o) { const int _oc = (w + 8 * _o) * 8; \
            qr[_o] = *(const u32x4*)(QK + (size_t)_row * 1024 + h * 128 + _oc); kr[_o] = *(const u32x4*)(QK + (size_t)_row * 1024 + 512 + h * 128 + _oc); \
            vr[_o] = *(const u32x4*)(P + (size_t)_row * PA + 2560 + h * 128 + _oc); } \
        scn = SCN[(size_t)_row * 8 + dir * 4 + h]; } while (0)
    ML_LOAD(0);
    for (int ci = 0; ci < 36; ++ci) {
        const int rowbase = ML_ROWBASE(ci);
        LAS float* GA = (LAS float*)(lds + ML_GA + (ci & 1) * 1024);
        const float av = scn.x, pm = scn.y, bc = scn.z;
        const float Mv = fmaxf(m, pm);
        const float M63 = __shfl(Mv, 63), b63 = __shfl(bc, 63);
        const float wend = __expf(av - M63);
        const float m_new = b63 + M63, decay = __expf(m - M63);
        if (w == 0) { GA[lane] = av; GA[64 + lane] = Mv; GA[128 + lane] = bc; if (lane == 0) GA[192] = m; }
#pragma unroll
        for (int o2 = 0; o2 < 2; ++o2) {
            const int oc = (w + 8 * o2) * 8;
            *(LAS u32x4*)(lds + ML_QS + lane * 272 + oc * 2) = qr[o2];
            *(LAS u32x4*)(lds + ML_KS + lane * 272 + oc * 2) = kr[o2];
            float kf[8]; unpack8(kr[o2], kf);
            const unsigned short* vs = (const unsigned short*)&vr[o2];
#pragma unroll
            for (int e = 0; e < 8; ++e) {
                ((LAS bf16_t*)(lds + ML_KWT))[(oc + e) * 72 + lane] = (bf16_t)(pk2(kf[e] * wend, 0.f) & 0xffffu);
                ((LAS bf16_t*)(lds + ML_VT))[(oc + e) * 72 + lane] = vs[e];
            }
        }
        LDS_BAR();
        if (ci + 1 < 36) ML_LOAD(ci + 1);
        {
            bf16x8 af[2];
#pragma unroll
            for (int ks = 0; ks < 2; ++ks) af[ks] = *(const LAS bf16x8*)(lds + ML_KWT + (16 * w + fr) * 144 + (32 * ks + 8 * fq) * 2);
#pragma unroll
            for (int vb = 0; vb < 9; ++vb) {
                accC[vb] = accC[vb] * decay;
#pragma unroll
                for (int ks = 0; ks < 2; ++ks) {
                    const bf16x8 bfv = *(const LAS bf16x8*)(lds + ML_VT + (16 * vb + fr) * 144 + (32 * ks + 8 * fq) * 2);
                    accC[vb] = __builtin_amdgcn_mfma_f32_16x16x32_bf16(af[ks], bfv, accC[vb], 0, 0, 0);
                }
            }
        }
        {
            const int tb = w >> 1;
            bf16x8 af[4];
#pragma unroll
            for (int ks = 0; ks < 4; ++ks) af[ks] = *(const LAS bf16x8*)(lds + ML_QS + (16 * tb + fr) * 272 + (32 * ks + 8 * fq) * 2);
#pragma unroll
            for (int si = 0; si < 2; ++si) {
                const int sb = 2 * (w & 1) + si;
                f32x4 acc = (f32x4){0.f, 0.f, 0.f, 0.f};
#pragma unroll
                for (int ks = 0; ks < 4; ++ks) {
                    const bf16x8 bfv = *(const LAS bf16x8*)(lds + ML_KS + (16 * sb + fr) * 272 + (32 * ks + 8 * fq) * 2);
                    acc = __builtin_amdgcn_mfma_f32_16x16x32_bf16(af[ks], bfv, acc, 0, 0, 0);
                }
                const int s = 16 * sb + fr; const float as = GA[s];
#pragma unroll
                for (int e = 0; e < 4; ++e) { const int t = 16 * tb + 4 * fq + e; const float val = (s <= t) ? acc[e] * __expf(as - GA[64 + t]) : 0.f;
                    ((LAS bf16_t*)(lds + ML_SS))[t * 72 + s] = (bf16_t)(pk2(val, 0.f) & 0xffffu); }
            }
        }
        LDS_BAR();
        f32x4 num[4]; f32x4 dnum = (f32x4){0.f, 0.f, 0.f, 0.f};
        const float mprev = GA[192];
        {
            bf16x8 bV[2], bC[4];
#pragma unroll
            for (int ks = 0; ks < 2; ++ks) bV[ks] = *(const LAS bf16x8*)(lds + ML_VT + (16 * w + fr) * 144 + (32 * ks + 8 * fq) * 2);
#pragma unroll
            for (int ks = 0; ks < 4; ++ks) bC[ks] = *(const LAS bf16x8*)(lds + ML_CBT + (16 * w + fr) * 272 + (32 * ks + 8 * fq) * 2);
#pragma unroll
            for (int tb = 0; tb < 4; ++tb) {
                f32x4 a1 = (f32x4){0.f, 0.f, 0.f, 0.f}, a2 = (f32x4){0.f, 0.f, 0.f, 0.f};
#pragma unroll
                for (int ks = 0; ks < 2; ++ks) { const bf16x8 af = *(const LAS bf16x8*)(lds + ML_SS + (16 * tb + fr) * 144 + (32 * ks + 8 * fq) * 2);
                    a1 = __builtin_amdgcn_mfma_f32_16x16x32_bf16(af, bV[ks], a1, 0, 0, 0); }
#pragma unroll
                for (int ks = 0; ks < 4; ++ks) { const bf16x8 af = *(const LAS bf16x8*)(lds + ML_QS + (16 * tb + fr) * 272 + (32 * ks + 8 * fq) * 2);
                    a2 = __builtin_amdgcn_mfma_f32_16x16x32_bf16(af, bC[ks], a2, 0, 0, 0); }
#pragma unroll
                for (int e = 0; e < 4; ++e) { const int t = 16 * tb + 4 * fq + e; num[tb][e] = a1[e] + __expf(mprev - GA[64 + t]) * a2[e]; }
            }
            if (w < 4) {
                const int tb = w;
                f32x4 a1 = (f32x4){0.f, 0.f, 0.f, 0.f}, a2 = (f32x4){0.f, 0.f, 0.f, 0.f};
#pragma unroll
                for (int ks = 0; ks < 2; ++ks) { const bf16x8 af = *(const LAS bf16x8*)(lds + ML_SS + (16 * tb + fr) * 144 + (32 * ks + 8 * fq) * 2);
                    const bf16x8 bb = *(const LAS bf16x8*)(lds + ML_VT + (128 + fr) * 144 + (32 * ks + 8 * fq) * 2);
                    a1 = __builtin_amdgcn_mfma_f32_16x16x32_bf16(af, bb, a1, 0, 0, 0); }
#pragma unroll
                for (int ks = 0; ks < 4; ++ks) { const bf16x8 af = *(const LAS bf16x8*)(lds + ML_QS + (16 * tb + fr) * 272 + (32 * ks + 8 * fq) * 2);
                    const bf16x8 bb = *(const LAS bf16x8*)(lds + ML_CBT + (128 + fr) * 272 + (32 * ks + 8 * fq) * 2);
                    a2 = __builtin_amdgcn_mfma_f32_16x16x32_bf16(af, bb, a2, 0, 0, 0); }
#pragma unroll
                for (int e = 0; e < 4; ++e) { const int t = 16 * tb + 4 * fq + e; dnum[e] = a1[e] + __expf(mprev - GA[64 + t]) * a2[e]; }
                if (fr == 0) {
#pragma unroll
                    for (int e = 0; e < 4; ++e) ((LAS float*)(lds + ML_DEN))[16 * tb + 4 * fq + e] = dnum[e];
                }
            }
        }
        LDS_BAR();
#pragma unroll
        for (int tb = 0; tb < 4; ++tb)
#pragma unroll
            for (int e = 0; e < 4; ++e) {
                const int t = 16 * tb + 4 * fq + e;
                const float dn = fmaxf(fabsf(((LAS float*)(lds + ML_DEN))[t]), __expf(-(GA[128 + t] + GA[64 + t])));
                const float hv = num[tb][e] * __builtin_amdgcn_rcpf(dn);
                const int row = rowbase + (dir == 0 ? t : 63 - t);
                HF[(size_t)row * 512 + h * 128 + 16 * w + fr] = (bf16_t)(pk2(hv, 0.f) & 0xffffu);
            }
#pragma unroll
        for (int vb = 0; vb < 9; ++vb) {
            u32x2 cw; cw.x = pk2(accC[vb][0], accC[vb][1]); cw.y = pk2(accC[vb][2], accC[vb][3]);
            *(LAS u32x2*)(lds + ML_CBT + (16 * vb + fr) * 272 + (16 * w + 4 * fq) * 2) = cw;
        }
        m = m_new;
    }
    __syncthreads();
#undef ML_ROWBASE
#undef ML_LOAD
}

__device__ void mix_phase(ArgsR a, int l, LAS unsigned char* lds, int slot, int nu_override) {
    unsigned* ctr = (unsigned*)(a.ws + WS_CTL) + slot + l;
    LAS int* su = (LAS int*)(lds + 131072);
    constexpr int NU = 128 + 2 * (1024 + 128);
    for (;;) {
        __syncthreads();
        if (tidx() == 0) *su = (int)atomicAdd(ctr, 1u);
        __syncthreads();
        int u = *su;
        if (u >= (nu_override ? nu_override : NU)) break;
        if (u < 128) { mlstm_unit(a, l, lds, u >> 3, (u >> 1) & 3, u & 1); continue; }
        u -= 128;
        int typeA = 0; if (u >= 1152) { typeA = 1; u -= 1152; }
        int isctx = 0, bb, kv, qb;
        if (u < 1024) { bb = u >> 6; kv = (u >> 5) & 1; qb = u & 31; } else { u -= 1024; isctx = 1; bb = u >> 3; kv = (u >> 2) & 1; qb = u & 3; }
        if (isctx && l == NL - 1) continue;
        attn_unit(a, l, lds, typeA, bb, kv, qb, isctx);
    }
}

__device__ void readout_phase(ArgsR a, int l) {
    const int tid = tidx(), lane = tid & 63, w = tid >> 6;
    const int gw = bidx() * 8 + w, NGW = gridDim.x * 8;
    const bf16_t* HF = (const bf16_t*)(a.ws + WS_HFB);
    const bf16_t* GS = (const bf16_t*)(a.ws + WS_RG0);
    bf16_t* YM = (bf16_t*)(a.ws + WS_Y3) + (size_t)2 * MT * 512;
    const float* hg = a.in[I_MNORM] + l * 512;
    float hgv[8];
#pragma unroll
    for (int e = 0; e < 8; ++e) hgv[e] = hg[8 * lane + e];
    const int rpw = (MT + NGW - 1) / NGW, m0 = gw * rpw, m1 = (m0 + rpw < MT) ? m0 + rpw : MT;
    if (m0 >= m1) return;
    u32x4 nf = *(const u32x4*)(HF + (size_t)m0 * 512 + 8 * lane), nb = *(const u32x4*)(HF + (size_t)MT * 512 + (size_t)m0 * 512 + 8 * lane), no = *(const u32x4*)(GS + (size_t)m0 * GSW + 8 * lane);
    for (int m = m0; m < m1; ++m) {
        const u32x4 cf = nf, cb = nb, co = no;
        if (m + 1 < m1) { nf = *(const u32x4*)(HF + (size_t)(m + 1) * 512 + 8 * lane); nb = *(const u32x4*)(HF + (size_t)MT * 512 + (size_t)(m + 1) * 512 + 8 * lane); no = *(const u32x4*)(GS + (size_t)(m + 1) * GSW + 8 * lane); }
        float f[8], bk[8], og[8];
        unpack8(cf, f); unpack8(cb, bk); unpack8(co, og);
        float ss = 0.f;
#pragma unroll
        for (int e = 0; e < 8; ++e) { f[e] += bk[e]; ss += f[e] * f[e]; }
        ss += __shfl_xor(ss, 1); ss += __shfl_xor(ss, 2); ss += __shfl_xor(ss, 4); ss += __shfl_xor(ss, 8);
        const float rms = 1.f / sqrtf(ss * (1.f / 128.f) + EPS);
#pragma unroll
        for (int e = 0; e < 8; ++e) f[e] = og[e] * (f[e] * rms * hgv[e]);
        *(u32x4*)(YM + (size_t)m * 512 + 8 * lane) = pack8(f);
    }
}

#define XB_TMO      128
#define XB_XCNT(j)  (256  + 64 * (j))
#define XB_XSUB(j)  (1280 + 64 * (j))
#define XB_XGEN(j)  (2304 + 64 * (j))
#define XB_TOP      3328
#define XB_TOPGEN   3392
#define XCD_BAR_WORDS 3456
#define XB_SPIN_CAP (1u << 20)
__device__ __forceinline__ unsigned xb_ld(unsigned* p)              { return __hip_atomic_load(p, __ATOMIC_RELAXED, __HIP_MEMORY_SCOPE_AGENT); }
__device__ __forceinline__ unsigned xb_add(unsigned* p, unsigned v) { return __hip_atomic_fetch_add(p, v, __ATOMIC_RELAXED, __HIP_MEMORY_SCOPE_AGENT); }
__device__ __forceinline__ unsigned xb_xcc_id() { return (unsigned)__builtin_amdgcn_s_getreg((3 << 11) | 20) & 0xFu; }
#define XB_SPIN(cond, bar) do { unsigned _sp = 0; while (cond) { __builtin_amdgcn_s_sleep(1); \
    if ((++_sp & 255u) == 0u) { if (xb_ld(&(bar)[XB_TMO])) break; if (_sp > XB_SPIN_CAP) { atomicAdd(&(bar)[XB_TMO], 1u); break; } } } } while (0)
__device__ __forceinline__ void xcd_barrier_complete(unsigned* bar, unsigned x, unsigned& nloc, unsigned& nx) {
    const unsigned G = gridDim.x;
    unsigned sum, cnt, mine, sp = 0u;
    for (;;) {
        sum = 0u; cnt = 0u; mine = 0u;
#pragma unroll
        for (unsigned j = 0; j < 16; ++j) { const unsigned c = xb_ld(&bar[XB_XCNT(j)]); sum += c; cnt += (c > 0u) ? 1u : 0u; mine = (j == x) ? c : mine; }
        if (sum == G) break;
        __builtin_amdgcn_s_sleep(1);
        if ((++sp & 255u) == 0u) { if (xb_ld(&bar[XB_TMO])) break; if (sp > XB_SPIN_CAP) { atomicAdd(&bar[XB_TMO], 1u); break; } }
    }
    nloc = mine > 0u ? mine : 1u; nx = cnt > 0u ? cnt : 1u;
}
__device__ __forceinline__ void xcd_barrier(unsigned* bar, unsigned x, volatile LAS unsigned* st) {
    asm volatile("s_waitcnt vmcnt(0)" ::: "memory");
    __syncthreads();
    if (threadIdx.x == 0) {
        __builtin_amdgcn_s_waitcnt(0);
        unsigned nloc = st[0], nx = st[1];
        if (nloc == 0u) { xcd_barrier_complete(bar, x, nloc, nx); st[0] = nloc; st[1] = nx; }
        const unsigned old = xb_add(&bar[XB_XSUB(x)], 1u);
        const unsigned gen = old / nloc;
        if (old + 1u == (gen + 1u) * nloc) {
            __builtin_amdgcn_fence(__ATOMIC_RELEASE, "agent");
            asm volatile("s_waitcnt vmcnt(0)" ::: "memory");
            const unsigned og = xb_add(&bar[XB_TOP], 1u);
            const unsigned tg = og / nx;
            if (og + 1u == (tg + 1u) * nx) xb_add(&bar[XB_TOPGEN], 1u);
            else XB_SPIN(xb_ld(&bar[XB_TOPGEN]) == tg, bar);
            __builtin_amdgcn_fence(__ATOMIC_ACQUIRE, "agent");
            xb_add(&bar[XB_XGEN(x)], 1u);
            asm volatile("s_waitcnt vmcnt(0)" ::: "memory");
        } else {
            XB_SPIN(xb_ld(&bar[XB_XGEN(x)]) == gen, bar);
            __builtin_amdgcn_fence(__ATOMIC_ACQUIRE, "agent");
            asm volatile("s_waitcnt vmcnt(0)" ::: "memory");
        }
    }
    __syncthreads();
}

__global__ void __launch_bounds__(512, 2) mk_fwd(Args a_kernarg) {
    extern __shared__ __attribute__((aligned(16))) unsigned char lds_raw[];
    LAS unsigned char* lds = (LAS unsigned char*)lds_raw;
    const int G = gridDim.x;
    const __attribute__((address_space(4))) Args* ap = (const __attribute__((address_space(4))) Args*)__builtin_amdgcn_kernarg_segment_ptr();
    const int ph_lo = ap->ph_lo, ph_hi = ap->ph_hi;
    volatile LAS unsigned* xb_st = (volatile LAS unsigned*)(lds + 131072 + 64);
    if (threadIdx.x == 0) { xb_st[0] = 0u; xb_st[1] = 0u; }
    const unsigned xb_x = xb_xcc_id();
    if (ph_hi - ph_lo > 1 && threadIdx.x == 0) (void)xb_add((unsigned*)(ap->ws + WS_BAR) + XB_XCNT(xb_x), 1u);
    __syncthreads();
    for (int ph = ph_lo; ph < ph_hi; ++ph) {
        asm volatile("" : "+s"(ap));
        ArgsR a = *ap;
        bf16_t* W = (bf16_t*)(a.ws + WS_W);
        bf16_t* HN = (bf16_t*)(a.ws + WS_HN);
        bf16_t* RG0 = (bf16_t*)(a.ws + WS_RG0);
        bf16_t* Y3 = (bf16_t*)(a.ws + WS_Y3);
        bf16_t* U = (bf16_t*)(a.ws + WS_HFB);
        bf16_t* YB = (bf16_t*)(a.ws + WS_QK);
        float* GMp = (float*)(a.ws + WS_GM);
        bool do_gemm = false, do_row = false;
        pg8::Gemm g{}; pg8::Order S{}; pg8::Epi E{}; RowP rp{};
        int l = 0, s = -1;
        if (ph == 0) {
            ;
        } else if (ph == 1) {
            rp = RowP{1, 0, 1, 0, 0, 0, 0, 0.f, MT, 0}; do_row = true;
        } else {
            l = (ph - 2) / 14; s = (ph - 2) - 14 * l;
            switch (s) {
            case 0: case 11:
                g = pg8::Gemm{HN, W + (s == 0 ? W_GU1 : W_GU2), MT, 5632, 1024, 0, 0}; S.init(MT, 5632, 1024, G, bidx(), 1, 0);
                E = pg8::Epi{1, RG0, FF, nullptr, -1, nullptr, nullptr, nullptr}; do_gemm = true; break;
            case 1: case 12: case 9:
                g = pg8::Gemm{s == 9 ? U : RG0, W + (s == 1 ? W_D1 : (s == 12 ? W_D2 : W_O)), MT, 1024, s == 9 ? 1024 : FF, 0, 0}; S.init(MT, 1024, g.K, G, bidx(), 1, (G == 256 && !(l == NL - 1 && s != 1)) ? TC / 256 : 0);
                E = pg8::Epi{0, YB, 1024, nullptr, -1, nullptr, nullptr, (bf16_t*)(a.ws + WS_END)}; do_gemm = true; break;
            case 3:
                g = pg8::Gemm{HN, W + W_INA, MT, PA, 1024, 0, 0}; S.init(MT, PA, 1024, G, bidx(), 1, 0);
                E = pg8::Epi{0, RG0, PA, GMp, 12, nullptr, a.in[I_QKN] + l * 128, nullptr}; do_gemm = true; break;
            case 6:
                g = pg8::Gemm{HN, W + W_INB, MT, GSW, 1024, 0, 0}; S.init(MT, GSW, 1024, G, bidx(), 1, 0);
                E = pg8::Epi{2, RG0, GSW, nullptr, -1, nullptr, nullptr, nullptr}; do_gemm = true; break;
            case 8:
                g = pg8::Gemm{Y3, W + W_B, MT, 1024, 512, (size_t)MT * 512 * 2, (size_t)1024 * 512 * 2}; S.init(MT, 1024, 512, G, bidx(), 3, 0);
                E = pg8::Epi{3, U, 1024, nullptr, -1, RG0, nullptr, nullptr}; do_gemm = true; break;
            case 2: rp = RowP{l == 0 ? 1 : 0, 1, 1, l, 0, l, 1, 0.5f, MT, G == 256}; do_row = true; break;
            case 10: rp = RowP{0, 1, 1, l, 1, l, 2, 1.0f, l == NL - 1 ? TL : MT, G == 256 && l != NL - 1}; do_row = true; break;
            case 13: rp = RowP{0, 1, l + 1 < NL ? 1 : 0, l, 2, l + 1, 0, 0.5f, l == NL - 1 ? TL : MT, G == 256 && l != NL - 1}; do_row = true; break;
            case 4: prep_phase(a, l, 2); break;
            case 5: { int nrep = PROBE_MIX_REPS; asm volatile("" : "+s"(nrep)); for (int rep = 0; rep < nrep; ++rep) mix_phase(a, l, lds, 16 + 16 * rep, rep ? 128 : 0); break; }
            case 7: readout_phase(a, l); break;
            }
        }
        if (do_gemm && l == NL - 1 && s >= 6) { g.M = TL; S.init(TL, g.N, g.K, G, bidx(), S.nz, 0); }
        if (do_gemm) {
            if (s == 8) pg8::gemm_phase<true>(lds, g, S, E); else pg8::gemm_phase<false>(lds, g, S, E);
        }
        if (do_row) row_phase(a, rp);
        {
            int cv_l = -1, lo1 = 0, hi1 = 0, lo2 = 0, hi2 = 0, wk = bidx(), nwk = G, pad = 0;
            if (ph == 0) { cv_l = 0; hi1 = 6544; pad = 1; }
            else if (ph >= 2) {
                const int l2 = (ph - 2) / 14, s2 = (ph - 2) - 14 * l2;
                if (l2 + 1 < NL) {
                    if (s2 == 13) { cv_l = l2 + 1; hi1 = 6544; pad = 1; }
                }
            }
            if (cv_l >= 0) convert_weights(a, cv_l, lds, lo1, hi1, lo2, hi2, wk, nwk, pad);
        }
        if (ph == 0) compute_mod(a, lds);
        if (ph + 1 < ph_hi) { if (ph_hi > NPH) cg::this_grid().sync();   else xcd_barrier((unsigned*)(a.ws + WS_BAR), xb_x, xb_st); }
    }
}

extern "C" void kernel_launch(void* const* d_in, const int* in_sizes, int n_in, void* d_out, int out_size, void* d_ws, size_t ws_size, hipStream_t stream) {
    static int grid = 0;
    if (grid == 0) {
        if (n_in != 19 || ws_size < WS_SCN + (size_t)MT * 8 * 16 || out_size != TL * DM) { fprintf(stderr, "kernel_launch: unexpected shapes (n_in %d, ws %zu, out %d)\n", n_in, ws_size, out_size); grid = -1; return; }
        int dev = 0, cus = 0, per_cu = 0;
        hipGetDevice(&dev); hipDeviceGetAttribute(&cus, hipDeviceAttributeMultiprocessorCount, dev);
        hipFuncSetAttribute((const void*)mk_fwd, hipFuncAttributeMaxDynamicSharedMemorySize, LDS_BYTES);
        hipOccupancyMaxActiveBlocksPerMultiprocessor(&per_cu, (const void*)mk_fwd, 512, LDS_BYTES);
        if (per_cu < 1) per_cu = 1;
        (void)hipGetLastError();
        grid = cus * per_cu;
    }
    if (grid < 0) return;
    (void)hipMemsetAsync((char*)d_ws + WS_CTL, 0, 4096 + 16384, stream);
    Args a{};
    for (int i = 0; i < 19; ++i) a.in[i] = (const float*)d_in[i];
    a.out = (float*)d_out; a.ws = (unsigned char*)d_ws;
#if MK_MULTI
    for (int ph = 0; ph < NPH; ++ph) {
        a.ph_lo = ph; a.ph_hi = ph + 1;
        hipLaunchKernelGGL(mk_fwd, dim3(grid), dim3(512), LDS_BYTES, stream, a);
    }
#else
    a.ph_lo = 0; a.ph_hi = NPH;
    void* args[] = {&a};
    hipError_t e = hipLaunchCooperativeKernel((const void*)mk_fwd, dim3(grid), dim3(512), args, LDS_BYTES, stream);
    if (e != hipSuccess) fprintf(stderr, "cooperative launch failed: %s (grid %d)\n", hipGetErrorString(e), grid);
#endif
}
```

```cpp
#include <hip/hip_runtime.h>
#include <hip/hip_cooperative_groups.h>
#include <cstdio>
#include <cstdint>
namespace cg = cooperative_groups;

#ifndef MK_MULTI
#define MK_MULTI 0
#endif

#ifndef PROBE_GEMM_REPS
#define PROBE_GEMM_REPS 1
#endif
#ifndef PROBE_SYNC_REPS
#define PROBE_SYNC_REPS 1
#endif
#ifndef PROBE_MIX_REPS
#define PROBE_MIX_REPS 1
#endif
#define LAS __attribute__((address_space(3)))
typedef unsigned short bf16_t;
typedef short bf16x8 __attribute__((ext_vector_type(8)));
typedef short s16x4 __attribute__((ext_vector_type(4)));
typedef float f32x2 __attribute__((ext_vector_type(2)));
typedef float f32x4 __attribute__((ext_vector_type(4)));
typedef float f32x16 __attribute__((ext_vector_type(16)));
typedef unsigned u32x4 __attribute__((ext_vector_type(4)));
typedef unsigned u32x2 __attribute__((ext_vector_type(2)));

constexpr int TL = 32768, TC = 4096, MT = TL + TC, DM = 1024, FF = 2816, NL = 4;
constexpr int SEQ = 2048, CTXL = 256, NB = 16;
constexpr int PA = 3328;
constexpr int GSW = 3584;
constexpr int INW = 6672;
constexpr float EPS = 1e-6f;
constexpr int NPH = 2 + 14 * NL;
constexpr int LDS_BYTES = 147456;

constexpr size_t MiB = 1u << 20;
constexpr size_t WS_CTL = 0;
constexpr size_t WS_BAR = 4096;
constexpr size_t WS_MOD = 4096 + 16384;
constexpr size_t WS_GM = WS_MOD + (size_t)NL * 17 * 9216 * 4;
constexpr size_t WS_W = 8 * MiB;
constexpr size_t WS_XC = 64 * MiB;
constexpr size_t WS_HN = 80 * MiB;
constexpr size_t WS_RG0 = 152 * MiB;
constexpr size_t WS_Y3 = 404 * MiB;
constexpr size_t WS_HFB = 512 * MiB;
constexpr size_t WS_QK = 584 * MiB;
constexpr size_t WS_END = 656 * MiB;
constexpr size_t WS_SCN = WS_END + 24 * MiB;
static_assert(WS_GM + (size_t)MT * 16 * 4 <= WS_W, "ws map");
constexpr size_t W_GU1 = 0, W_D1 = W_GU1 + (size_t)5632 * 1024, W_GU2 = W_D1 + (size_t)1024 * 2816, W_D2 = W_GU2 + (size_t)5632 * 1024;
constexpr size_t W_INA = W_D2 + (size_t)1024 * 2816, W_INB = W_INA + (size_t)PA * 1024, W_B = W_INB + (size_t)GSW * 1024, W_O = W_B + (size_t)3 * 1024 * 512, W_END = W_O + (size_t)1024 * 1024;
static_assert(WS_W + W_END * 2 <= WS_XC, "weights fit");

__device__ __forceinline__ int tidx() { int t = threadIdx.x; asm volatile("" : "+v"(t)); return t; }
__device__ __forceinline__ int bidx() { int t = blockIdx.x; asm volatile("" : "+s"(t)); return t; }
__device__ __forceinline__ float bf2f(unsigned short u) { return __builtin_bit_cast(float, (unsigned)u << 16); }
__device__ __forceinline__ unsigned pk2(float lo, float hi) { unsigned r; asm volatile("v_cvt_pk_bf16_f32 %0, %1, %2" : "=v"(r) : "v"(lo), "v"(hi)); return r; }
__device__ __forceinline__ float wave_sum(float v) {
#pragma unroll
    for (int o = 1; o < 64; o <<= 1) v += __shfl_xor(v, o);
    return v;
}
__device__ __forceinline__ float max3f_(float a, float b, float c) { float r; asm("v_max3_f32 %0, %1, %2, %3" : "=v"(r) : "v"(a), "v"(b), "v"(c)); return r; }
#define LDS_BAR() asm volatile("s_waitcnt lgkmcnt(0)\n\ts_barrier" ::: "memory")
__device__ __forceinline__ float sigmoidf_(float x) { return __builtin_amdgcn_rcpf(1.f + __builtin_amdgcn_exp2f(-1.4426950408889634f * x)); }
__device__ __forceinline__ float siluf_(float x) { return x * __builtin_amdgcn_rcpf(1.f + __builtin_amdgcn_exp2f(-1.4426950408889634f * x)); }
__device__ __forceinline__ void unpack8(u32x4 w, float* f) {
    f[0] = __builtin_bit_cast(float, w.x << 16); f[1] = __builtin_bit_cast(float, w.x & 0xffff0000u);
    f[2] = __builtin_bit_cast(float, w.y << 16); f[3] = __builtin_bit_cast(float, w.y & 0xffff0000u);
    f[4] = __builtin_bit_cast(float, w.z << 16); f[5] = __builtin_bit_cast(float, w.z & 0xffff0000u);
    f[6] = __builtin_bit_cast(float, w.w << 16); f[7] = __builtin_bit_cast(float, w.w & 0xffff0000u);
}
__device__ __forceinline__ u32x4 pack8(const float* f) { u32x4 w; w.x = pk2(f[0], f[1]); w.y = pk2(f[2], f[3]); w.z = pk2(f[4], f[5]); w.w = pk2(f[6], f[7]); return w; }

namespace pg8 {
constexpr int BM = 256, BK = 64, HALF = 128, HTB = HALF * BK * 2, NXCD = 8, WGM = 8;
__host__ __device__ __forceinline__ int lds_byte(int r, int c) { const int st = (r >> 4) * 2 + (c >> 5), rr = r & 15, cc = c & 31, ob = rr * 64 + cc * 2; return st * 1024 + (ob ^ (((ob >> 9) & 1) << 5)); }
__host__ __device__ __forceinline__ void stage_rc(int b, int& R, int& C) { const int st = b / 1024, sb = b % 1024, swz = sb ^ (((sb >> 9) & 1) << 5); R = (st >> 1) * 16 + swz / 64; C = (st & 1) * 32 + (swz % 64) / 2; }
__host__ __device__ __forceinline__ int perm32(int rho) { const int n = rho >> 4, i = rho & 15; return 8 * (i >> 2) + 4 * n + (i & 3); }

struct Unit { int pm, pn, z, k0, nt, part; };
struct Gemm { const bf16_t* A; const bf16_t* Bt; int M, N, K; size_t zA, zB; };

struct Order {
    int nM, nN, nwg, G, c, nz, ktiles, nsplit_tiles;
    __device__ void init(int M, int N, int K, int G_, int c_, int nz_, int split_mtiles) {
        nM = M / BM - split_mtiles; nN = N / BM; nwg = nM * nN; G = G_; c = c_; nz = nz_; ktiles = K / BK; nsplit_tiles = split_mtiles; }
    __device__ bool next(int i, Unit& u) const {
        const int ii = i / nz; u.z = i - ii * nz;
        const long L = (long)ii * G + c;
        u.k0 = 0; u.nt = ktiles; u.part = 0;
        if (L >= nwg) {
            const int q = (int)(L - nwg); if (q >= nsplit_tiles * nN * 4) return false;
            const int kp = q & 3, tile = q >> 2;
            u.pm = nM + tile / nN; u.pn = tile % nN; u.part = kp;
            const int base = (ktiles / 4) & ~1, extra = (ktiles - 4 * base) / 2;
            u.nt = base + (kp < extra ? 2 : 0); u.k0 = kp * base + 2 * (kp < extra ? kp : extra);
            return true;
        }
        int wgid = (int)L; { const int q = nwg / NXCD, r = nwg % NXCD, xcd = wgid % NXCD, off = wgid / NXCD; wgid = (xcd < r ? xcd * (q + 1) : r * (q + 1) + (xcd - r) * q) + off; }
        const int nig = WGM * nN, gid = wgid / nig, fm = gid * WGM, gsz = (nM - fm) < WGM ? (nM - fm) : WGM;
        u.pm = fm + ((wgid % nig) % gsz); u.pn = (wgid % nig) / gsz; return true;
    }
};

struct Epi {
    int MODE; bf16_t* O; int ldc; float* gm; int gm_pn; const bf16_t* GS; const float* qkn; bf16_t* O2;
    __device__ __forceinline__ void operator()(const f32x4 (&acc)[2][2][4][2], const Unit& u, int wr, int wc, int fr, int fq) const {
        const int row0 = u.pm * BM + wr * 64 + fr;
        if (MODE == 1) {
            const int col0 = u.pn * 128 + wc * 32 + 8 * fq;
#pragma unroll
            for (int ai = 0; ai < 2; ++ai)
#pragma unroll
                for (int m = 0; m < 4; ++m) {
                    bf16_t* rowp = O + (size_t)(row0 + ai * HALF + m * 16) * ldc + col0;
                    float v[8];
#pragma unroll
                    for (int n = 0; n < 2; ++n)
#pragma unroll
                        for (int j = 0; j < 4; j += 2) {
                            const f32x2 g = (f32x2){acc[ai][0][m][n][j], acc[ai][0][m][n][j + 1]}, up = (f32x2){acc[ai][1][m][n][j], acc[ai][1][m][n][j + 1]};
                            const f32x2 e = g * (f32x2){-1.4426950408889634f, -1.4426950408889634f};
                            f32x2 d; d.x = __builtin_amdgcn_exp2f(e.x); d.y = __builtin_amdgcn_exp2f(e.y);
                            d = d + (f32x2){1.f, 1.f};
                            f32x2 r; r.x = __builtin_amdgcn_rcpf(d.x); r.y = __builtin_amdgcn_rcpf(d.y);
                            const f32x2 o2 = (g * up) * r;
                            v[4 * n + j] = o2.x; v[4 * n + j + 1] = o2.y;
                        }
                    *(u32x4*)rowp = pack8(v);
                    __builtin_amdgcn_sched_barrier(0);
                }
        } else if (MODE == 0 && gm != nullptr && u.pn < 6 && (wc < 2 || (u.pn != 2 && u.pn != 5))) {
            const int col0 = u.pn * BM + wc * 32 + 8 * fq;
            const int axis = fq >> 1, pb = 8 * (fq & 1);
            const bool isB = u.pn >= 3;
            const float* gn = qkn + ((u.pn == 5) ? 64 : 0) + axis * 32 + pb;
            constexpr float FRQ[8] = {1.f, 0.5623413251903491f, 0.31622776601683794f, 0.17782794100389228f, 0.1f, 0.05623413251903491f, 0.031622776601683794f, 0.017782794100389228f};
            const float fsc = (fq & 1) ? 0.01f : 1.f;
#pragma unroll
            for (int ai = 0; ai < 2; ++ai)
#pragma unroll
                for (int m = 0; m < 4; ++m) {
                    const int row = row0 + ai * HALF + m * 16;
                    float x1[8], x2[8];
#pragma unroll
                    for (int n = 0; n < 2; ++n)
#pragma unroll
                        for (int j = 0; j < 4; ++j) { x1[4 * n + j] = acc[ai][0][m][n][j]; x2[4 * n + j] = acc[ai][1][m][n][j]; }
                    if (isB) {
                        float ss = 0.f;
#pragma unroll
                        for (int e = 0; e < 8; ++e) ss += x1[e] * x1[e] + x2[e] * x2[e];
                        ss += __shfl_xor(ss, 16); ss += __shfl_xor(ss, 32);
                        const float rms = 1.f / sqrtf(ss * (1.f / 64.f) + EPS);
#pragma unroll
                        for (int e = 0; e < 8; ++e) { x1[e] = x1[e] * rms * gn[e]; x2[e] = x2[e] * rms * gn[16 + e]; }
                    }
                    if (row < TL) {
                        const int t = row & (SEQ - 1); const float pos = (float)(axis == 0 ? (t >> 6) : (t & 63)) * fsc;
#pragma unroll
                        for (int e = 0; e < 8; ++e) { const float ang = pos * FRQ[e]; const float c = __cosf(ang), sn = __sinf(ang);
                            const float o1 = x1[e] * c - x2[e] * sn, o2 = x2[e] * c + x1[e] * sn; x1[e] = o1; x2[e] = o2; }
                    }
                    *(u32x4*)(O + (size_t)row * ldc + col0) = pack8(x1);
                    *(u32x4*)(O + (size_t)row * ldc + col0 + HALF) = pack8(x2);
                    __builtin_amdgcn_sched_barrier(0);
                }
        } else {
            const int col0 = u.pn * BM + wc * 32 + 8 * fq;
#pragma unroll
            for (int ai = 0; ai < 2; ++ai)
#pragma unroll
                for (int m = 0; m < 4; ++m) {
                    const int row = row0 + ai * HALF + m * 16;
#pragma unroll
                    for (int bj = 0; bj < 2; ++bj) {
                        const int col = col0 + bj * HALF;
                        float v[8];
#pragma unroll
                        for (int n = 0; n < 2; ++n)
#pragma unroll
                            for (int j = 0; j < 4; ++j) v[4 * n + j] = acc[ai][bj][m][n][j];
                        if (MODE == 0) {
                            bf16_t* dst = u.part == 0 ? O + (size_t)row * ldc + col : O2 + ((size_t)(u.part - 1) * TC + (row - TL)) * 1024 + col;
                            *(u32x4*)dst = pack8(v);
                            if (gm != nullptr && u.pn == gm_pn && bj == 0 && wc == 0 && fq < 2) {
                                float* g = gm + (size_t)row * 16 + 8 * fq;
                                *(f32x4*)g = (f32x4){v[0], v[1], v[2], v[3]}; *(f32x4*)(g + 4) = (f32x4){v[4], v[5], v[6], v[7]};
                            }
                        } else if (MODE == 2) {
#pragma unroll
                            for (int e = 0; e < 8; ++e) v[e] = sigmoidf_(v[e]);
                            *(u32x4*)(O + (size_t)row * ldc + col) = pack8(v);
                        } else {
                            float g[8]; unpack8(*(const u32x4*)(GS + (size_t)row * GSW + 512 + u.z * 1024 + col), g);
                            bf16_t* up = O + (size_t)row * ldc + col;
                            if (u.z == 0) {
#pragma unroll
                                for (int e = 0; e < 8; ++e) v[e] *= g[e];
                            } else {
                                float o[8]; unpack8(*(const u32x4*)up, o);
#pragma unroll
                                for (int e = 0; e < 8; ++e) v[e] = o[e] + v[e] * g[e];
                            }
                            *(u32x4*)up = pack8(v);
                        }
                        __builtin_amdgcn_sched_barrier(0);
                    }
                }
        }
    }
    __device__ __forceinline__ bool merge3(f32x4 (&acc)[2][2][4][2], const Unit& u, int wr, int wc, int fr, int fq) const {
        const int row0 = u.pm * BM + wr * 64 + fr;
            const int col0 = u.pn * BM + wc * 32 + 8 * fq;
            const int zn = u.z < 2 ? u.z + 1 : 2;
#pragma unroll
            for (int ai = 0; ai < 2; ++ai) {
                u32x4 gv[4][2], hv[4][2];
#pragma unroll
                for (int m = 0; m < 4; ++m)
#pragma unroll
                    for (int bj = 0; bj < 2; ++bj) {
                        const bf16_t* gp = GS + (size_t)(row0 + ai * HALF + m * 16) * GSW + 512 + col0 + bj * HALF;
                        gv[m][bj] = __builtin_nontemporal_load((const u32x4*)(gp + u.z * 1024));
                        hv[m][bj] = __builtin_nontemporal_load((const u32x4*)(gp + zn * 1024));
                    }
#pragma unroll
                for (int m = 0; m < 4; ++m)
#pragma unroll
                    for (int bj = 0; bj < 2; ++bj) {
                        const int row = row0 + ai * HALF + m * 16;
                        float g[8], h[8]; unpack8(gv[m][bj], g); unpack8(hv[m][bj], h);
                        if (u.z < 2) {
#pragma unroll
                            for (int n = 0; n < 2; ++n)
#pragma unroll
                                for (int j = 0; j < 4; ++j) acc[ai][bj][m][n][j] *= g[4 * n + j] * __builtin_amdgcn_rcpf(fmaxf(h[4 * n + j], 1e-30f));
                        } else {
                            float v[8];
#pragma unroll
                            for (int n = 0; n < 2; ++n)
#pragma unroll
                                for (int j = 0; j < 4; ++j) v[4 * n + j] = acc[ai][bj][m][n][j] * g[4 * n + j];
                            *(u32x4*)(O + (size_t)row * ldc + col0 + bj * HALF) = pack8(v);
                        }
                    }
                __builtin_amdgcn_sched_barrier(0);
            }
        return u.z < 2;
    }
};

template <bool KEEP3, class EpiT>
__device__ __forceinline__ void gemm_phase(LAS unsigned char* lds, const Gemm g, const Order& S, const EpiT& E) {
    const int tid_ = tidx();
    const int tid = tid_, wid = __builtin_amdgcn_readfirstlane(tid >> 6), lane = tid & 63, wr = wid >> 2, wc = wid & 3, fr = lane & 15, fq = lane >> 4;
    const int K = g.K;
    unsigned voffA[2], voffB[2];
#pragma unroll
    for (int i = 0; i < 2; ++i) { int R, C; stage_rc(tid * 16 + i * 8192, R, C); const int Rb = (R & ~31) + perm32(R & 31);
        voffA[i] = (unsigned)(R * K + C) * 2u; voffB[i] = (unsigned)(Rb * K + C) * 2u; }
    const size_t kstep = (size_t)(BK * 2);
    const size_t hstep = (size_t)HALF * K * 2;
    const size_t tstep = 2 * hstep;
    const unsigned ldsw = (unsigned)wid * 1024u;
    const int aoff = lds_byte(wr * 64 + fr, fq * 8), boff = lds_byte(wc * 32 + fr, fq * 8);
#define PG8_SA(b, h) (((b) * 2 + (h)) * HTB)
#define PG8_SB(b, h) ((4 + (b) * 2 + (h)) * HTB)
#define PG8_STAGE(bufoff, gbase, voff) do { _Pragma("unroll") for (int _i = 0; _i < 2; ++_i) \
        __builtin_amdgcn_global_load_lds((const unsigned*)((const char*)(gbase) + (voff)[_i]), (LAS unsigned*)(lds + (bufoff) + ldsw + _i * 8192), 16, 0, 0); } while (0)
#define PG8_LDA(dst, b, h) do { _Pragma("unroll") for (int m = 0; m < 4; ++m) _Pragma("unroll") for (int k = 0; k < 2; ++k) dst[m][k] = *(const LAS bf16x8*)(lds + PG8_SA(b, h) + aoff + m * 2048 + k * 1024); } while (0)
#define PG8_LDB(dst, b, h) do { _Pragma("unroll") for (int n = 0; n < 2; ++n) _Pragma("unroll") for (int k = 0; k < 2; ++k) dst[n][k] = *(const LAS bf16x8*)(lds + PG8_SB(b, h) + boff + n * 2048 + k * 1024); } while (0)
#define PG8_MMA(ai, bj, At, Bt) do { __builtin_amdgcn_s_setprio(1); _Pragma("unroll") for (int m = 0; m < 4; ++m) _Pragma("unroll") for (int n = 0; n < 2; ++n) _Pragma("unroll") for (int k = 0; k < 2; ++k) \
        acc[ai][bj][m][n] = __builtin_amdgcn_mfma_f32_16x16x32_bf16(Bt[n][k], At[m][k], acc[ai][bj][m][n], 0, 0, 0); __builtin_amdgcn_s_setprio(0); } while (0)
#define PG8_WAIT_V(n) asm volatile("s_waitcnt vmcnt(" #n ")" ::: "memory")
#define PG8_WAIT_L(n) asm volatile("s_waitcnt lgkmcnt(" #n ")" ::: "memory")
#define PG8_BAR __builtin_amdgcn_s_barrier()
#define PG8_SCHED __builtin_amdgcn_sched_barrier(0)
    Unit cur, nxt; int ui = 0;
    if (!S.next(0, cur)) return;
    f32x4 acc[2][2][4][2];
#pragma unroll
    for (int a = 0; a < 2; ++a)
#pragma unroll
        for (int b = 0; b < 2; ++b)
#pragma unroll
            for (int m = 0; m < 4; ++m)
#pragma unroll
                for (int n = 0; n < 2; ++n) acc[a][b][m][n] = (f32x4){0.f, 0.f, 0.f, 0.f};
    bf16x8 At[4][2], B0[2][2], B1[2][2];
    const char* cA = (const char*)g.A + (size_t)cur.z * g.zA + (size_t)cur.pm * tstep + (size_t)cur.k0 * kstep; const char* cB = (const char*)g.Bt + (size_t)cur.z * g.zB + (size_t)cur.pn * tstep + (size_t)cur.k0 * kstep;
    PG8_STAGE(PG8_SB(0, 0), cB, voffB); PG8_STAGE(PG8_SB(0, 1), cB + hstep, voffB); PG8_STAGE(PG8_SA(0, 0), cA, voffA); PG8_STAGE(PG8_SA(0, 1), cA + hstep, voffA);
    if (wr == 1) PG8_BAR;
    PG8_WAIT_V(2); PG8_BAR;
    PG8_STAGE(PG8_SB(1, 0), cB + kstep, voffB); PG8_STAGE(PG8_SA(1, 0), cA + kstep, voffA); PG8_STAGE(PG8_SB(1, 1), cB + hstep + kstep, voffB);
    PG8_WAIT_V(6); PG8_BAR;
    for (;;) {
        const bool has_next = S.next(ui + 1, nxt);
        const char* nA = has_next ? (const char*)g.A + (size_t)nxt.z * g.zA + (size_t)nxt.pm * tstep + (size_t)nxt.k0 * kstep : cA; const char* nB = has_next ? (const char*)g.Bt + (size_t)nxt.z * g.zB + (size_t)nxt.pn * tstep + (size_t)nxt.k0 * kstep : cB;
        const int nt = cur.nt;
        for (int t = 0; t < nt; t += 2) {
            const bool last = (t == nt - 2);
            const char* a1 = cA + (size_t)(t + 1) * kstep;
            const char* a2 = last ? nA : cA + (size_t)(t + 2) * kstep; const char* b2 = last ? nB : cB + (size_t)(t + 2) * kstep;
            const char* a3 = a2 + kstep; const char* b3 = b2 + kstep;
            PG8_LDB(B0, 0, 0); PG8_LDB(B1, 0, 1); PG8_SCHED; PG8_LDA(At, 0, 0); PG8_STAGE(PG8_SA(1, 1), a1 + hstep, voffA);
            PG8_WAIT_V(8); PG8_WAIT_L(0); PG8_BAR; PG8_MMA(0, 0, At, B0); PG8_MMA(0, 1, At, B1); PG8_BAR; PG8_SCHED;
            PG8_LDA(At, 0, 1); PG8_STAGE(PG8_SB(0, 0), b2, voffB); PG8_STAGE(PG8_SB(0, 1), b2 + hstep, voffB); PG8_STAGE(PG8_SA(0, 0), a2, voffA);
            PG8_WAIT_V(8); PG8_WAIT_L(0); PG8_BAR; PG8_MMA(1, 0, At, B0); PG8_MMA(1, 1, At, B1); PG8_BAR; PG8_SCHED;
            PG8_LDB(B0, 1, 0); PG8_LDB(B1, 1, 1); PG8_SCHED; PG8_LDA(At, 1, 0); PG8_STAGE(PG8_SA(0, 1), a2 + hstep, voffA);
            PG8_WAIT_V(8); PG8_WAIT_L(0); PG8_BAR; PG8_MMA(0, 0, At, B0); PG8_MMA(0, 1, At, B1); PG8_BAR; PG8_SCHED;
            PG8_LDA(At, 1, 1); PG8_STAGE(PG8_SB(1, 0), b3, voffB); PG8_STAGE(PG8_SB(1, 1), b3 + hstep, voffB); PG8_STAGE(PG8_SA(1, 0), a3, voffA);
            PG8_WAIT_V(8); PG8_WAIT_L(0); PG8_BAR; PG8_MMA(1, 0, At, B0); PG8_MMA(1, 1, At, B1); PG8_BAR; PG8_SCHED;
        }
        if (wr == 0) PG8_BAR;
        bool keep = false;
        if constexpr (KEEP3) keep = E.merge3(acc, cur, wr, wc, fr, fq); else E(acc, cur, wr, wc, fr, fq);
        if (!has_next) break;
        if (!keep) {
#pragma unroll
            for (int a = 0; a < 2; ++a)
#pragma unroll
                for (int b = 0; b < 2; ++b)
#pragma unroll
                    for (int m = 0; m < 4; ++m)
#pragma unroll
                        for (int n = 0; n < 2; ++n) acc[a][b][m][n] = (f32x4){0.f, 0.f, 0.f, 0.f};
        }
        cur = nxt; cA = nA; cB = nB; ++ui;
        if (wr == 1) PG8_BAR;
    }
    PG8_WAIT_V(0);
    PG8_BAR;
#undef PG8_SA
#undef PG8_SB
#undef PG8_STAGE
#undef PG8_LDA
#undef PG8_LDB
#undef PG8_MMA
#undef PG8_WAIT_V
#undef PG8_WAIT_L
#undef PG8_BAR
#undef PG8_SCHED
}
}

struct Args {
    const float* in[19];
    float* out; unsigned char* ws;
    int ph_lo, ph_hi;
};
typedef const __attribute__((address_space(4))) Args& ArgsR;
enum { I_X = 0, I_C, I_CTX, I_CCTX, I_WADA, I_BADA, I_NORMG, I_WG, I_WU, I_WD, I_WIN, I_SINK, I_QKN, I_CONVW, I_CONVB, I_GATEB, I_MNORM, I_WB, I_WO };

__device__ __forceinline__ bf16_t* wdst_row(bf16_t* W, int type, int sub, int n, int& K) {
    switch (type) {
    case 0: K = 1024; return W + (sub ? W_GU2 : W_GU1) + (size_t)((n >> 7) * 256 + (n & 127)) * 1024;
    case 1: K = 1024; return W + (sub ? W_GU2 : W_GU1) + (size_t)((n >> 7) * 256 + 128 + (n & 127)) * 1024;
    case 2: K = 2816; return W + (sub ? W_D2 : W_D1) + (size_t)n * 2816;
    case 3: K = 1024;
        if (n < 1536) {
            const int tb = n >= 768 ? 3 : 0, nn = n >= 768 ? n - 768 : n, d = nn & 63;
            int tile, w, qk = 1;
            if (nn < 512) { const int head = nn >> 6; tile = tb + (head >> 2); w = head & 3; }
            else if (nn < 640) { tile = tb + 2; w = (nn - 512) >> 6; }
            else { tile = tb + 2; w = 2 + ((nn - 640) >> 6); qk = 0; }
            const int sl = qk ? ((d >> 4) & 1) * 32 + (d >> 5) * 16 + (d & 15) : d;
            return W + W_INA + (size_t)(256 * tile + (sl >> 5) * 128 + 32 * w + (sl & 31)) * 1024;
        }
        if (n < 3072) return W + W_INA + (size_t)n * 1024;
        if (n < 3584) return W + W_INB + (size_t)(n - 3072) * 1024;
        if (n < 3600) return W + W_INA + (size_t)(3072 + n - 3584) * 1024;
        return W + W_INB + (size_t)(512 + n - 3600) * 1024;
    case 4: K = 512; return W + W_B + (size_t)sub * 1024 * 512 + (size_t)n * 512;
    default: K = 1024; return W + W_O + (size_t)n * 1024;
    }
}
__device__ void convert_weights(ArgsR a, int l, LAS unsigned char* lds, int lo1, int hi1, int lo2, int hi2, int wk, int nwk, int do_pad) {
    LAS float* s = (LAS float*)lds;
    bf16_t* W = (bf16_t*)(a.ws + WS_W);
    const int tid = tidx();
    constexpr int NT_FF = 16 * 44, NT_IN = 16 * 105, NT_B = 8 * 16, NT_O = 16 * 16;
    constexpr int NITEMS = 6 * NT_FF + NT_IN + 3 * NT_B + NT_O;
    const int n1 = hi1 - lo1, ntot = n1 + (hi2 - lo2);
    for (int ii = wk; ii < ntot; ii += nwk) {
        const int it = ii < n1 ? lo1 + ii : lo2 + (ii - n1);
        int r = it, type, sub = 0, K, N; const float* src;
        if (r < 4 * NT_FF) { const int q = r / NT_FF; r -= q * NT_FF; type = q & 1; sub = q >> 1; K = 1024; N = 2816;
            src = (type == 0 ? a.in[I_WG] : a.in[I_WU]) + ((size_t)l * 2 + sub) * 1024 * 2816; }
        else if ((r -= 4 * NT_FF) < 2 * NT_FF) { sub = r / NT_FF; r -= sub * NT_FF; type = 2; K = 2816; N = 1024; src = a.in[I_WD] + ((size_t)l * 2 + sub) * 2816 * 1024; }
        else if ((r -= 2 * NT_FF) < NT_IN) { type = 3; K = 1024; N = INW; src = a.in[I_WIN] + (size_t)l * 1024 * INW; }
        else if ((r -= NT_IN) < 3 * NT_B) { sub = r / NT_B; r -= sub * NT_B; type = 4; K = 512; N = 1024; src = a.in[I_WB] + ((size_t)l * 3 + sub) * 512 * 1024; }
        else { r -= 3 * NT_B; type = 5; K = 1024; N = 1024; src = a.in[I_WO] + (size_t)l * 1024 * 1024; }
        const int nkb = K / 64, nb = r / nkb, kb = r - nb * nkb, k0 = kb * 64, n0 = nb * 64;
        __syncthreads();
#pragma unroll
        for (int i = 0; i < 8; ++i) { const int kk = i * 8 + (tid >> 6), nn = tid & 63; s[kk * 65 + nn] = (n0 + nn < N) ? __builtin_nontemporal_load(src + (size_t)(k0 + kk) * N + n0 + nn) : 0.f; }
        __syncthreads();
        const int n = tid >> 3, c = tid & 7;
        if (n0 + n < N) {
            int Kd; bf16_t* d = wdst_row(W, type, sub, n0 + n, Kd);
            float v[8];
#pragma unroll
            for (int i = 0; i < 8; ++i) v[i] = s[(8 * c + i) * 65 + n];
            *(u32x4*)(d + k0 + 8 * c) = pack8(v);
        }
    }
    if (do_pad) for (int i = wk * 512 + tid; i < (PA - 3088) * 1024 / 8; i += nwk * 512) *(u32x4*)(W + W_INA + (size_t)3088 * 1024 + (size_t)i * 8) = (u32x4){0u, 0u, 0u, 0u};
    __syncthreads();
}

__device__ void compute_mod(ArgsR a, LAS unsigned char* lds) {
    LAS float* sc = (LAS float*)lds;
    LAS float* red = (LAS float*)(lds + 17 * 1024 * 4);
    const int tid = tidx(), lane = tid & 63, w = tid >> 6;
    float* MOD = (float*)(a.ws + WS_MOD);
    constexpr int NITEMS = NL * 144;
    if ((int)bidx() >= NITEMS) return;
    __syncthreads();
    for (int i = tid; i < 17 * 1024; i += 512) { const int r = i >> 10, k = i & 1023; const float v = r < 16 ? a.in[I_C][r * 1024 + k] : a.in[I_CCTX][k]; sc[i] = siluf_(v); }
    __syncthreads();
    for (int it = bidx(); it < NITEMS; it += gridDim.x) {
        const int l = it / 144, j0 = (it - l * 144) * 64;
        const float* wp = a.in[I_WADA] + (size_t)l * 1024 * 9216 + (size_t)(w * 128) * 9216 + j0 + lane;
        float acc[17];
#pragma unroll
        for (int r = 0; r < 17; ++r) acc[r] = 0.f;
        for (int k8 = 0; k8 < 128; k8 += 16) {
            float wv[16];
#pragma unroll
            for (int u = 0; u < 16; ++u) wv[u] = __builtin_nontemporal_load(wp + (size_t)(k8 + u) * 9216);
#pragma unroll
            for (int u = 0; u < 16; ++u)
#pragma unroll
                for (int r = 0; r < 17; ++r) acc[r] += sc[r * 1024 + w * 128 + k8 + u] * wv[u];
        }
#pragma unroll
        for (int r = 0; r < 17; ++r) red[(w * 17 + r) * 64 + lane] = acc[r];
        __syncthreads();
        for (int i = tid; i < 17 * 64; i += 512) { const int r = i >> 6, col = i & 63; float sacc = a.in[I_BADA][l * 9216 + j0 + col];
#pragma unroll
            for (int ww = 0; ww < 8; ++ww) sacc += red[(ww * 17 + r) * 64 + col];
            MOD[((size_t)l * 17 + r) * 9216 + j0 + col] = sacc; }
        __syncthreads();
    }
}

struct RowP { int init, has_res, has_next, l, kpost, lnext, knext; float w; int nrows; int ksplit; };
__device__ void row_phase(ArgsR a, const RowP p) {
    const int tid = tidx(), lane = tid & 63, w = tid >> 6;
    const int gw = bidx() * 8 + w, NGW = gridDim.x * 8;
    const float* MOD = (const float*)(a.ws + WS_MOD);
    float* xc = (float*)(a.ws + WS_XC);
    bf16_t* HN = (bf16_t*)(a.ws + WS_HN);
    const bf16_t* YB = (const bf16_t*)(a.ws + WS_QK);
    const float* ng = a.in[I_NORMG];
    const int NR = p.nrows, rpw = (NR + NGW - 1) / NGW, m0 = gw * rpw, m1 = (m0 + rpw < NR) ? m0 + rpw : NR;
    if (m0 >= m1) return;
    f32x4 gpost[4], gpre[4], gate[4], sh[4], scl[4];
#pragma unroll
    for (int j = 0; j < 4; ++j) {
        gpost[j] = p.has_res ? *(const f32x4*)(ng + ((size_t)p.l * 6 + 2 * p.kpost + 1) * 1024 + 4 * lane + 256 * j) : (f32x4){0.f, 0.f, 0.f, 0.f};
        gpre[j] = p.has_next ? *(const f32x4*)(ng + ((size_t)p.lnext * 6 + 2 * p.knext) * 1024 + 4 * lane + 256 * j) : (f32x4){0.f, 0.f, 0.f, 0.f};
        gate[j] = sh[j] = scl[j] = (f32x4){0.f, 0.f, 0.f, 0.f};
    }
    int r_cur = -1;
#define RP_XR(m) (p.init ? ((m) < TL ? a.in[I_X] + (size_t)(m) * 1024 : a.in[I_CTX] + (size_t)((m) - TL) * 1024) : ((m) < TL ? a.out + (size_t)(m) * 1024 : xc + (size_t)((m) - TL) * 1024))
    f32x4 vn[4]; u32x2 yn[4], yp[3][4];
#define RP_PART(m, pp, j) (__builtin_nontemporal_load((const u32x2*)((const bf16_t*)(a.ws + WS_END) + ((size_t)(pp) * TC + ((m) - TL)) * 1024 + 4 * lane + 256 * (j))))
#pragma unroll
    for (int pp = 0; pp < 3; ++pp)
#pragma unroll
        for (int j = 0; j < 4; ++j) yp[pp][j] = (u32x2){0u, 0u};
    {
        const float* xr = RP_XR(m0);
#pragma unroll
        for (int j = 0; j < 4; ++j) { vn[j] = __builtin_nontemporal_load((const f32x4*)(xr + 4 * lane + 256 * j)); yn[j] = p.has_res ? __builtin_nontemporal_load((const u32x2*)(YB + (size_t)m0 * 1024 + 4 * lane + 256 * j)) : (u32x2){0u, 0u}; }
        if (p.ksplit && m0 >= TL) {
#pragma unroll
            for (int pp = 0; pp < 3; ++pp)
#pragma unroll
                for (int j = 0; j < 4; ++j) yp[pp][j] = RP_PART(m0, pp, j);
        }
    }
    for (int m = m0; m < m1; ++m) {
        f32x4 v[4]; u32x2 yq[4], yq2[3][4];
#pragma unroll
        for (int j = 0; j < 4; ++j) { v[j] = vn[j]; yq[j] = yn[j]; yq2[0][j] = yp[0][j]; yq2[1][j] = yp[1][j]; yq2[2][j] = yp[2][j]; }
        if (m + 1 < m1) {
            const float* xr = RP_XR(m + 1);
#pragma unroll
            for (int j = 0; j < 4; ++j) { vn[j] = __builtin_nontemporal_load((const f32x4*)(xr + 4 * lane + 256 * j)); if (p.has_res) yn[j] = __builtin_nontemporal_load((const u32x2*)(YB + (size_t)(m + 1) * 1024 + 4 * lane + 256 * j)); }
            if (p.ksplit && m + 1 >= TL) {
#pragma unroll
                for (int pp = 0; pp < 3; ++pp)
#pragma unroll
                    for (int j = 0; j < 4; ++j) yp[pp][j] = RP_PART(m + 1, pp, j);
            }
        }
        const int r = m < TL ? (m >> 11) : 16;
        if (r != r_cur) {
            r_cur = r;
#pragma unroll
            for (int j = 0; j < 4; ++j) {
                if (p.has_res) gate[j] = *(const f32x4*)(MOD + (((size_t)p.l * 17 + r) * 9 + 3 * p.kpost + 2) * 1024 + 4 * lane + 256 * j) * p.w;
                if (p.has_next) { sh[j] = *(const f32x4*)(MOD + (((size_t)p.lnext * 17 + r) * 9 + 3 * p.knext) * 1024 + 4 * lane + 256 * j);
                    scl[j] = *(const f32x4*)(MOD + (((size_t)p.lnext * 17 + r) * 9 + 3 * p.knext + 1) * 1024 + 4 * lane + 256 * j) + 1.f; }
            }
        }
        float* xw = m < TL ? a.out + (size_t)m * 1024 : xc + (size_t)(m - TL) * 1024;
        if (p.has_res) {
            f32x4 y[4]; float ss = 0.f;
#pragma unroll
            for (int j = 0; j < 4; ++j) { const u32x2 q = yq[j];
                y[j] = (f32x4){__builtin_bit_cast(float, q.x << 16), __builtin_bit_cast(float, q.x & 0xffff0000u), __builtin_bit_cast(float, q.y << 16), __builtin_bit_cast(float, q.y & 0xffff0000u)};
                if (p.ksplit && m >= TL) {
#pragma unroll
                    for (int pp = 0; pp < 3; ++pp) { const u32x2 q2 = yq2[pp][j];
                        y[j] = y[j] + (f32x4){__builtin_bit_cast(float, q2.x << 16), __builtin_bit_cast(float, q2.x & 0xffff0000u), __builtin_bit_cast(float, q2.y << 16), __builtin_bit_cast(float, q2.y & 0xffff0000u)}; }
                }
                ss += (y[j].x * y[j].x + y[j].y * y[j].y) + (y[j].z * y[j].z + y[j].w * y[j].w); }
            const float rms = 1.f / sqrtf(wave_sum(ss) * (1.f / 1024.f) + EPS);
#pragma unroll
            for (int j = 0; j < 4; ++j) v[j] = v[j] + gate[j] * ((y[j] * rms) * gpost[j]);
        }
        if (p.has_res) {
#pragma unroll
            for (int j = 0; j < 4; ++j) __builtin_nontemporal_store(v[j], (f32x4*)(xw + 4 * lane + 256 * j));
        }
        if (p.has_next) {
            float ss = 0.f;
#pragma unroll
            for (int j = 0; j < 4; ++j) ss += (v[j].x * v[j].x + v[j].y * v[j].y) + (v[j].z * v[j].z + v[j].w * v[j].w);
            const float rms = 1.f / sqrtf(wave_sum(ss) * (1.f / 1024.f) + EPS);
#pragma unroll
            for (int j = 0; j < 4; ++j) { const f32x4 h = ((v[j] * rms) * gpre[j]) * scl[j] + sh[j];
                u32x2 o; o.x = pk2(h.x, h.y); o.y = pk2(h.z, h.w);
                *(u32x2*)(HN + (size_t)m * 1024 + 4 * lane + 256 * j) = o; }
        }
    }
#undef RP_XR
#undef RP_PART
}

__device__ void prep_phase(ArgsR a, int l, int parts) {
    bf16_t* P = (bf16_t*)(a.ws + WS_RG0);
    bf16_t* QK = (bf16_t*)(a.ws + WS_QK);
    const int gt = bidx() * 512 + tidx(), NT = gridDim.x * 512;
    const float* qkn = a.in[I_QKN] + l * 128;
    if (parts & 1) for (long i = gt; i < (long)MT * 160; i += NT) {
        const int row = (int)(i / 160), rem = (int)(i - (long)row * 160), hs = rem >> 3, j = rem & 7;
        int col; const float* gn = nullptr;
        if (hs < 8) col = 64 * hs; else if (hs < 10) col = 512 + 64 * (hs - 8); else if (hs < 18) { col = 768 + 64 * (hs - 10); gn = qkn; } else { col = 1280 + 64 * (hs - 18); gn = qkn + 64; }
        const int axis = j >> 2, p0 = (j & 3) * 4;
        bf16_t* base = P + (size_t)row * PA + col + axis * 32 + p0;
        const u32x2 r1 = *(const u32x2*)base, r2 = *(const u32x2*)(base + 16);
        float x1[4] = {__builtin_bit_cast(float, r1.x << 16), __builtin_bit_cast(float, r1.x & 0xffff0000u), __builtin_bit_cast(float, r1.y << 16), __builtin_bit_cast(float, r1.y & 0xffff0000u)};
        float x2[4] = {__builtin_bit_cast(float, r2.x << 16), __builtin_bit_cast(float, r2.x & 0xffff0000u), __builtin_bit_cast(float, r2.y << 16), __builtin_bit_cast(float, r2.y & 0xffff0000u)};
        if (gn) {
            float ss = 0.f;
#pragma unroll
            for (int e = 0; e < 4; ++e) ss += x1[e] * x1[e] + x2[e] * x2[e];
            ss += __shfl_xor(ss, 1); ss += __shfl_xor(ss, 2); ss += __shfl_xor(ss, 4);
            const float rms = 1.f / sqrtf(ss * (1.f / 64.f) + EPS);
#pragma unroll
            for (int e = 0; e < 4; ++e) { x1[e] = x1[e] * rms * gn[axis * 32 + p0 + e]; x2[e] = x2[e] * rms * gn[axis * 32 + 16 + p0 + e]; }
        }
        if (row < TL) {
            const int t = row & (SEQ - 1); const float pos = (float)(axis == 0 ? (t >> 6) : (t & 63));
#pragma unroll
            for (int e = 0; e < 4; ++e) {
                const float freq = exp2f(-(float)(p0 + e) * (13.287712379549449f / 16.f));
                const float ang = pos * freq; const float c = __cosf(ang), s = __sinf(ang);
                const float o1 = x1[e] * c - x2[e] * s, o2 = x2[e] * c + x1[e] * s; x1[e] = o1; x2[e] = o2;
            }
        }
        if (gn || row < TL) {
            u32x2 o1, o2; o1.x = pk2(x1[0], x1[1]); o1.y = pk2(x1[2], x1[3]); o2.x = pk2(x2[0], x2[1]); o2.y = pk2(x2[2], x2[3]);
            *(u32x2*)base = o1; *(u32x2*)(base + 16) = o2;
        }
    }
    if (parts & 2) {
        const float* cw = a.in[I_CONVW] + (size_t)l * 5 * 1024; const float* cb = a.in[I_CONVB] + (size_t)l * 1024;
        const int oct = gt & 127, run = gt >> 7, nruns = NT >> 7, c0 = oct * 8;
        const int rpr = (MT + nruns - 1) / nruns;
        const int r0 = run * rpr, r1 = (r0 + rpr < MT) ? r0 + rpr : MT;
        float wt[5][8], bs[8];
#pragma unroll
        for (int j = 0; j < 5; ++j)
#pragma unroll
            for (int e = 0; e < 8; ++e) wt[j][e] = cw[j * 1024 + c0 + e];
#pragma unroll
        for (int e = 0; e < 8; ++e) bs[e] = cb[c0 + e];
        const float scl = c0 < 512 ? 0.08838834764831845f : 1.f;
#define CV_LD(rr) (((rr) >= 0 && (rr) < MT) ? *(const u32x4*)(P + (size_t)(rr) * PA + 1536 + c0) : (u32x4){0u, 0u, 0u, 0u})
        if (r0 < r1) {
            u32x4 win[8], nxt[4];
#pragma unroll
            for (int j = 0; j < 8; ++j) win[j] = CV_LD(r0 - 2 + j);
            for (int base = r0; base < r1; base += 4) {
#pragma unroll
                for (int j = 0; j < 4; ++j) nxt[j] = CV_LD(base + 6 + j);
#pragma unroll
                for (int q = 0; q < 4; ++q) {
                    const int row = base + q;
                    if (row < r1) {
                        int t, len; if (row < TL) { t = row & (SEQ - 1); len = SEQ; } else { t = (row - TL) & (CTXL - 1); len = CTXL; }
                        float acc[8];
#pragma unroll
                        for (int e = 0; e < 8; ++e) acc[e] = bs[e];
#pragma unroll
                        for (int j = 0; j < 5; ++j) {
                            const int tt = t + j - 2;
                            if (tt >= 0 && tt < len) {
                                float x[8]; unpack8(win[q + j], x);
#pragma unroll
                                for (int e = 0; e < 8; ++e) acc[e] += wt[j][e] * x[e];
                            }
                        }
#pragma unroll
                        for (int e = 0; e < 8; ++e) acc[e] = siluf_(acc[e]) * scl;
                        *(u32x4*)(QK + (size_t)row * 1024 + c0) = pack8(acc);
                    }
                }
#pragma unroll
                for (int j = 0; j < 4; ++j) { win[j] = win[j + 4]; win[j + 4] = nxt[j]; }
            }
        }
#undef CV_LD
    }
    if (parts & 2) {
        const float* GM = (const float*)(a.ws + WS_GM);
        f32x4* SCN = (f32x4*)(a.ws + WS_SCN);
        const int lane = threadIdx.x & 63, gw = gt >> 6, NGW = NT >> 6;
        for (int it = gw; it < (MT / 64) * 8; it += NGW) {
            const int ch = it >> 3, dh = it & 7, dir = dh >> 2, h = dh & 3;
            const int row = ch * 64 + (dir == 0 ? lane : 63 - lane);
            const float iv = GM[(size_t)row * 16 + dir * 8 + h] + a.in[I_GATEB][l * 16 + dir * 8 + h];
            const float fv = GM[(size_t)row * 16 + dir * 8 + 4 + h] + a.in[I_GATEB][l * 16 + dir * 8 + 4 + h];
            const float lf = fminf(fv, 0.f) - log1pf(__expf(-fabsf(fv)));
            float bc = lf;
#pragma unroll
            for (int o2 = 1; o2 < 64; o2 <<= 1) { const float t = __shfl_up(bc, o2); if (lane >= o2) bc += t; }
            const float av = iv - bc;
            float pm = av;
#pragma unroll
            for (int o2 = 1; o2 < 64; o2 <<= 1) { const float t = __shfl_up(pm, o2); if (lane >= o2) pm = fmaxf(pm, t); }
            SCN[(size_t)row * 8 + dh] = (f32x4){av, pm, bc, 0.f};
        }
    }
}

__device__ __forceinline__ void attn_tile(LAS unsigned char* lds, const unsigned cb, const unsigned kf_off, const unsigned vf_off, const bf16x8 (&qf)[4], f32x16 (&o)[2], float& m_run, float& l_run,
                                          const int typeA, const int ti, const int jlo, const int tq, const int hh) {
    const float C2 = 0.125f * 1.4426950408889634f;
    f32x16 st[4];
    {
        bf16x8 kf[4][4];
#pragma unroll
        for (int ks = 0; ks < 4; ++ks)
#pragma unroll
            for (int kt = 0; kt < 4; ++kt) kf[ks][kt] = *(const LAS bf16x8*)(lds + cb + kf_off + kt * (32 * 144) + ks * 32);
#pragma unroll
        for (int kt = 0; kt < 4; ++kt)
#pragma unroll
            for (int e = 0; e < 16; ++e) st[kt][e] = 0.f;
        __builtin_amdgcn_sched_barrier(0);
#pragma unroll
        for (int ks = 0; ks < 4; ++ks)
#pragma unroll
            for (int kt = 0; kt < 4; ++kt) st[kt] = __builtin_amdgcn_mfma_f32_32x32x16_bf16(kf[ks][kt], qf[ks], st[kt], 0, 0, 0);
    }
    s16x4 vfa[4][2][2], vfb[4][2][2];
#pragma unroll
    for (int kt = 0; kt < 4; ++kt)
#pragma unroll
        for (int s2 = 0; s2 < 2; ++s2)
#pragma unroll
            for (int dt = 0; dt < 2; ++dt) {
                const unsigned va = (cb ? 24576u : 0u) + vf_off + (unsigned)((32 * kt + 16 * s2) * 192 + dt * 64);
                vfa[kt][s2][dt] = __builtin_bit_cast(s16x4, __builtin_amdgcn_ds_read_tr16_b64_v4i16((LAS s16x4*)(lds + va)));
                vfb[kt][s2][dt] = __builtin_bit_cast(s16x4, __builtin_amdgcn_ds_read_tr16_b64_v4i16((LAS s16x4*)(lds + va + 8 * 192)));
            }
    __builtin_amdgcn_sched_barrier(0);
    if (typeA && ti >= 2) {
        const int s0 = 128 * (jlo + ti - 2);
#pragma unroll
        for (int kt = 0; kt < 4; ++kt)
#pragma unroll
            for (int e = 0; e < 16; ++e) { const int s = s0 + 32 * kt + (e & 3) + 8 * (e >> 2) + 4 * hh; const int d = tq - s; if (d > 128 || d < -128) st[kt][e] = -INFINITY; }
    }
    float mx0 = fmaxf(st[0][0], st[1][0]), mx1 = fmaxf(st[2][0], st[3][0]);
#pragma unroll
    for (int e = 1; e < 16; ++e) { mx0 = max3f_(mx0, st[0][e], st[1][e]); mx1 = max3f_(mx1, st[2][e], st[3][e]); }
    float mx = fmaxf(mx0, mx1);
    { const auto rr = __builtin_amdgcn_permlane32_swap(__builtin_bit_cast(unsigned, mx), __builtin_bit_cast(unsigned, mx), false, false);
      mx = fmaxf(__builtin_bit_cast(float, rr[0]), __builtin_bit_cast(float, rr[1])); }
    const float m_new = fmaxf(m_run, mx * C2);
    const float alpha = __builtin_amdgcn_exp2f(m_run - m_new);
    m_run = m_new;
    f32x2 psa = (f32x2){0.f, 0.f}, psb = (f32x2){0.f, 0.f};
    const f32x2 c2v = (f32x2){C2, C2}, mnv = (f32x2){m_new, m_new};
#pragma unroll
    for (int kt = 0; kt < 4; kt += 2)
#pragma unroll
        for (int e = 0; e < 16; e += 2) {
            f32x2 va = (f32x2){st[kt][e], st[kt][e + 1]}, vb = (f32x2){st[kt + 1][e], st[kt + 1][e + 1]};
            va = va * c2v - mnv; vb = vb * c2v - mnv;
            va.x = __builtin_amdgcn_exp2f(va.x); va.y = __builtin_amdgcn_exp2f(va.y); vb.x = __builtin_amdgcn_exp2f(vb.x); vb.y = __builtin_amdgcn_exp2f(vb.y);
            psa += va; psb += vb;
            st[kt][e] = va.x; st[kt][e + 1] = va.y; st[kt + 1][e] = vb.x; st[kt + 1][e + 1] = vb.y;
        }
    const float ps0 = psa.x + psa.y, ps1 = psb.x + psb.y;
    l_run = l_run * alpha + (ps0 + ps1);
#pragma unroll
    for (int e = 0; e < 16; ++e) { o[0][e] *= alpha; o[1][e] *= alpha; }
#pragma unroll
    for (int kt = 0; kt < 4; ++kt)
#pragma unroll
        for (int s2 = 0; s2 < 2; ++s2) {
            u32x4 pw; pw.x = pk2(st[kt][8 * s2 + 0], st[kt][8 * s2 + 1]); pw.y = pk2(st[kt][8 * s2 + 2], st[kt][8 * s2 + 3]);
            pw.z = pk2(st[kt][8 * s2 + 4], st[kt][8 * s2 + 5]); pw.w = pk2(st[kt][8 * s2 + 6], st[kt][8 * s2 + 7]);
            const bf16x8 pf = __builtin_bit_cast(bf16x8, pw);
#pragma unroll
            for (int dt = 0; dt < 2; ++dt) {
                const s16x4 v0 = vfa[kt][s2][dt], v1 = vfb[kt][s2][dt];
                const bf16x8 vf = (bf16x8){v0[0], v0[1], v0[2], v0[3], v1[0], v1[1], v1[2], v1[3]};
                o[dt] = __builtin_amdgcn_mfma_f32_32x32x16_bf16(vf, pf, o[dt], 0, 0, 0);
            }
        }
}

__device__ void attn_unit(ArgsR a, int l, LAS unsigned char* lds, int typeA, int b, int kv, int qb, int isctx) {
    const bf16_t* P = (const bf16_t*)(a.ws + WS_RG0);
    bf16_t* Y = (bf16_t*)(a.ws + WS_Y3) + (typeA ? 0 : (size_t)MT * 512);
    const int tid_ = tidx();
    const int tid = tid_, lane = tid & 63, w = __builtin_amdgcn_readfirstlane(tid >> 6), r = lane & 31, hh = lane >> 5;
    const int tb256 = typeA ? 0 : 768;
    const int kcol = tb256 + 512 + 32 * kv, vcol = tb256 + 512 + 32 * (2 + kv);
    const int g = w >> 1, half = w & 1, head = kv * 4 + g;
    const int qrow0 = isctx ? TL + b * CTXL + qb * 64 : b * SEQ + qb * 64;
    const int qrow = qrow0 + 32 * half + r;
    const int tq = qb * 64 + 32 * half + r;
    bf16x8 qf[4];
#pragma unroll
    for (int ks = 0; ks < 4; ++ks) { const int c = 2 * ks + hh; qf[ks] = *(const bf16x8*)(P + (size_t)qrow * PA + tb256 + 256 * (head >> 2) + 32 * (head & 3) + (c >> 2) * 128 + (c & 3) * 8); }
    int jlo = 0, nlat = 0;
    if (!isctx) { if (typeA) { const int t0 = qb * 64; jlo = (t0 - 128) < 0 ? 0 : (t0 - 128) >> 7; int jhi = (t0 + 191) >> 7; if (jhi > 15) jhi = 15; nlat = jhi - jlo + 1; } else { jlo = 0; nlat = 16; } }
    const int ntiles = 2 + nlat;
    const float C2 = 0.125f * 1.4426950408889634f;
    f32x16 o[2];
#pragma unroll
    for (int e = 0; e < 16; ++e) { o[0][e] = 0.f; o[1][e] = 0.f; }
    float m_run = -INFINITY, l_run = 0.f;
    const int srow = tid >> 3, sch = tid & 7, scol = (sch >> 2) * 128 + (sch & 3) * 8;
    const unsigned st_off = (unsigned)(srow * 72 + sch * 8) * 2u;
    const int i16 = lane & 15, g16 = (lane >> 4) & 1;
    const unsigned kf_off = (unsigned)(r * 72 + 8 * hh) * 2u;
    const unsigned vf_off = 36864u + (unsigned)((4 * hh + (i16 >> 2)) * 96 + 16 * g16 + 4 * (i16 & 3)) * 2u;
    const unsigned sv_off = (unsigned)(srow * 96 + sch * 8) * 2u;
#define AT_BASE(t) ((t) < 2 ? TL + b * CTXL + 128 * (t) : b * SEQ + 128 * (jlo + (t) - 2))
#define AT_LOAD(t, kreg, vreg) do { const int _kb = AT_BASE(t); \
        kreg[0] = *(const u32x4*)(P + (size_t)(_kb + srow) * PA + kcol + scol); kreg[1] = *(const u32x4*)(P + (size_t)(_kb + 64 + srow) * PA + kcol + scol); \
        vreg[0] = *(const u32x4*)(P + (size_t)(_kb + srow) * PA + vcol + scol); vreg[1] = *(const u32x4*)(P + (size_t)(_kb + 64 + srow) * PA + vcol + scol); } while (0)
#define AT_STORE(bo, kreg, vreg) do { *(LAS u32x4*)(lds + (bo) + st_off) = kreg[0]; *(LAS u32x4*)(lds + (bo) + 9216 + st_off) = kreg[1]; \
        *(LAS u32x4*)(lds + 36864 + ((bo) ? 24576u : 0u) + sv_off) = vreg[0]; *(LAS u32x4*)(lds + 36864 + ((bo) ? 24576u : 0u) + 12288 + sv_off) = vreg[1]; } while (0)
    u32x4 kr0[2], vr0[2], kr1[2], vr1[2];
    AT_LOAD(0, kr0, vr0);
    __syncthreads();
    AT_STORE(0u, kr0, vr0);
    AT_LOAD(1, kr1, vr1);
    { const int tn = 2 < ntiles ? 2 : ntiles - 1; AT_LOAD(tn, kr0, vr0); }
    LDS_BAR();
    for (int ti = 0; ti < ntiles; ti += 2) {
        attn_tile(lds, 0u, kf_off, vf_off, qf, o, m_run, l_run, typeA, ti, jlo, tq, hh);
        AT_STORE(18432u, kr1, vr1);
        { const int tn = ti + 3 < ntiles ? ti + 3 : ntiles - 1; AT_LOAD(tn, kr1, vr1); }
        LDS_BAR();
        if (ti + 1 < ntiles) attn_tile(lds, 18432u, kf_off, vf_off, qf, o, m_run, l_run, typeA, ti + 1, jlo, tq, hh);
        AT_STORE(0u, kr0, vr0);
        { const int tn = ti + 4 < ntiles ? ti + 4 : ntiles - 1; AT_LOAD(tn, kr0, vr0); }
        LDS_BAR();
    }
#undef AT_BASE
#undef AT_LOAD
#undef AT_STORE
    float lt = l_run + __shfl_xor(l_run, 32);
    if (typeA) lt += exp2f(a.in[I_SINK][l * 8 + head] * 1.4426950408889634f - m_run);
    const float inv = 1.f / lt;
    bf16_t* yr = Y + (size_t)qrow * 512 + head * 64;
#pragma unroll
    for (int dt = 0; dt < 2; ++dt)
#pragma unroll
        for (int rg = 0; rg < 4; ++rg) {
            u32x2 ow; ow.x = pk2(o[dt][4 * rg] * inv, o[dt][4 * rg + 1] * inv); ow.y = pk2(o[dt][4 * rg + 2] * inv, o[dt][4 * rg + 3] * inv);
            *(u32x2*)(yr + 32 * dt + 8 * rg + 4 * hh) = ow;
        }
}

constexpr int ML_QS = 0, ML_KS = 17408, ML_KWT = 34816, ML_VT = 53248, ML_CBT = 73984, ML_SS = 113152, ML_GA = 122368, ML_DEN = 124416;
__device__ void mlstm_unit(ArgsR a, int l, LAS unsigned char* lds, int b, int h, int dir) {
    const bf16_t* P = (const bf16_t*)(a.ws + WS_RG0);
    const bf16_t* QK = (const bf16_t*)(a.ws + WS_QK);
    const f32x4* SCN = (const f32x4*)(a.ws + WS_SCN);
    bf16_t* HF = (bf16_t*)(a.ws + WS_HFB) + (size_t)dir * MT * 512;
    const int tid_ = tidx();
    const int tid = tid_, lane = tid & 63, w = __builtin_amdgcn_readfirstlane(tid >> 6), fr = lane & 15, fq = lane >> 4;
    __syncthreads();
    for (int i = tid; i < 39168 / 4; i += 512) ((LAS unsigned*)(lds + ML_CBT))[i] = 0u;
    for (int i = tid; i < 16 * 72; i += 512) { const int rr = i / 72, cc = i - rr * 72; ((LAS bf16_t*)(lds + ML_VT))[(128 + rr) * 72 + cc] = (rr == 0 && cc < 64) ? (bf16_t)0x3F80 : (bf16_t)0; }
    f32x4 accC[9];
#pragma unroll
    for (int v = 0; v < 9; ++v) accC[v] = (f32x4){0.f, 0.f, 0.f, 0.f};
    float m = 0.f;
    u32x4 qr[2], kr[2], vr[2]; f32x4 scn;
#define ML_ROWBASE(ci) ((ci) < 4 ? TL + b * CTXL + (dir == 0 ? (ci) : 3 - (ci)) * 64 : b * SEQ + (dir == 0 ? (ci) - 4 : 35 - (ci)) * 64)
#define ML_LOAD(ci) do { const int _row = ML_ROWBASE(ci) + (dir == 0 ? lane : 63 - lane); \
        _Pragma("unroll") for (int _o = 0; _o < 2; ++_o) { const int _oc = (w + 8 * _o) * 8; \
            qr[_o] = *(const u32x4*)(QK + (size_t)_row * 1024 + h * 128 + _oc); kr[_o] = *(const u32x4*)(QK + (size_t)_row * 1024 + 512 + h * 128 + _oc); \
            vr[_o] = *(const u32x4*)(P + (size_t)_row * PA + 2560 + h * 128 + _oc); } \
        scn = SCN[(size_t)_row * 8 + dir * 4 + h]; } while (0)
    ML_LOAD(0);
    for (int ci = 0; ci < 36; ++ci) {
        const int rowbase = ML_ROWBASE(ci);
        LAS float* GA = (LAS float*)(lds + ML_GA + (ci & 1) * 1024);
        const float av = scn.x, pm = scn.y, bc = scn.z;
        const float Mv = fmaxf(m, pm);
        const float M63 = __shfl(Mv, 63), b63 = __shfl(bc, 63);
        const float wend = __expf(av - M63);
        const float m_new = b63 + M63, decay = __expf(m - M63);
        if (w == 0) { GA[lane] = av; GA[64 + lane] = Mv; GA[128 + lane] = bc; if (lane == 0) GA[192] = m; }
#pragma unroll
        for (int o2 = 0; o2 < 2; ++o2) {
            const int oc = (w + 8 * o2) * 8;
            *(LAS u32x4*)(lds + ML_QS + lane * 272 + oc * 2) = qr[o2];
            *(LAS u32x4*)(lds + ML_KS + lane * 272 + oc * 2) = kr[o2];
            float kf[8]; unpack8(kr[o2], kf);
            const unsigned short* vs = (const unsigned short*)&vr[o2];
#pragma unroll
            for (int e = 0; e < 8; ++e) {
                ((LAS bf16_t*)(lds + ML_KWT))[(oc + e) * 72 + lane] = (bf16_t)(pk2(kf[e] * wend, 0.f) & 0xffffu);
                ((LAS bf16_t*)(lds + ML_VT))[(oc + e) * 72 + lane] = vs[e];
            }
        }
        LDS_BAR();
        if (ci + 1 < 36) ML_LOAD(ci + 1);
        {
            bf16x8 af[2];
#pragma unroll
            for (int ks = 0; ks < 2; ++ks) af[ks] = *(const LAS bf16x8*)(lds + ML_KWT + (16 * w + fr) * 144 + (32 * ks + 8 * fq) * 2);
#pragma unroll
            for (int vb = 0; vb < 9; ++vb) {
                accC[vb] = accC[vb] * decay;
#pragma unroll
                for (int ks = 0; ks < 2; ++ks) {
                    const bf16x8 bfv = *(const LAS bf16x8*)(lds + ML_VT + (16 * vb + fr) * 144 + (32 * ks + 8 * fq) * 2);
                    accC[vb] = __builtin_amdgcn_mfma_f32_16x16x32_bf16(af[ks], bfv, accC[vb], 0, 0, 0);
                }
            }
        }
        {
            const int tb = w >> 1;
            bf16x8 af[4];
#pragma unroll
            for (int ks = 0; ks < 4; ++ks) af[ks] = *(const LAS bf16x8*)(lds + ML_QS + (16 * tb + fr) * 272 + (32 * ks + 8 * fq) * 2);
#pragma unroll
            for (int si = 0; si < 2; ++si) {
                const int sb = 2 * (w & 1) + si;
                f32x4 acc = (f32x4){0.f, 0.f, 0.f, 0.f};
#pragma unroll
                for (int ks = 0; ks < 4; ++ks) {
                    const bf16x8 bfv = *(const LAS bf16x8*)(lds + ML_KS + (16 * sb + fr) * 272 + (32 * ks + 8 * fq) * 2);
                    acc = __builtin_amdgcn_mfma_f32_16x16x32_bf16(af[ks], bfv, acc, 0, 0, 0);
                }
                const int s = 16 * sb + fr; const float as = GA[s];
#pragma unroll
                for (int e = 0; e < 4; ++e) { const int t = 16 * tb + 4 * fq + e; const float val = (s <= t) ? acc[e] * __expf(as - GA[64 + t]) : 0.f;
                    ((LAS bf16_t*)(lds + ML_SS))[t * 72 + s] = (bf16_t)(pk2(val, 0.f) & 0xffffu); }
            }
        }
        LDS_BAR();
        f32x4 num[4]; f32x4 dnum = (f32x4){0.f, 0.f, 0.f, 0.f};
        const float mprev = GA[192];
        {
            bf16x8 bV[2], bC[4];
#pragma unroll
            for (int ks = 0; ks < 2; ++ks) bV[ks] = *(const LAS bf16x8*)(lds + ML_VT + (16 * w + fr) * 144 + (32 * ks + 8 * fq) * 2);
#pragma unroll
            for (int ks = 0; ks < 4; ++ks) bC[ks] = *(const LAS bf16x8*)(lds + ML_CBT + (16 * w + fr) * 272 + (32 * ks + 8 * fq) * 2);
#pragma unroll
            for (int tb = 0; tb < 4; ++tb) {
                f32x4 a1 = (f32x4){0.f, 0.f, 0.f, 0.f}, a2 = (f32x4){0.f, 0.f, 0.f, 0.f};
#pragma unroll
                for (int ks = 0; ks < 2; ++ks) { const bf16x8 af = *(const LAS bf16x8*)(lds + ML_SS + (16 * tb + fr) * 144 + (32 * ks + 8 * fq) * 2);
                    a1 = __builtin_amdgcn_mfma_f32_16x16x32_bf16(af, bV[ks], a1, 0, 0, 0); }
#pragma unroll
                for (int ks = 0; ks < 4; ++ks) { const bf16x8 af = *(const LAS bf16x8*)(lds + ML_QS + (16 * tb + fr) * 272 + (32 * ks + 8 * fq) * 2);
                    a2 = __builtin_amdgcn_mfma_f32_16x16x32_bf16(af, bC[ks], a2, 0, 0, 0); }
#pragma unroll
                for (int e = 0; e < 4; ++e) { const int t = 16 * tb + 4 * fq + e; num[tb][e] = a1[e] + __expf(mprev - GA[64 + t]) * a2[e]; }
            }
            if (w < 4) {
                const int tb = w;
                f32x4 a1 = (f32x4){0.f, 0.f, 0.f, 0.f}, a2 = (f32x4){0.f, 0.f, 0.f, 0.f};
#pragma unroll
                for (int ks = 0; ks < 2; ++ks) { const bf16x8 af = *(const LAS bf16x8*)(lds + ML_SS + (16 * tb + fr) * 144 + (32 * ks + 8 * fq) * 2);
                    const bf16x8 bb = *(const LAS bf16x8*)(lds + ML_VT + (128 + fr) * 144 + (32 * ks + 8 * fq) * 2);
                    a1 = __builtin_amdgcn_mfma_f32_16x16x32_bf16(af, bb, a1, 0, 0, 0); }
#pragma unroll
                for (int ks = 0; ks < 4; ++ks) { const bf16x8 af = *(const LAS bf16x8*)(lds + ML_QS + (16 * tb + fr) * 272 + (32 * ks + 8 * fq) * 2);
                    const bf16x8 bb = *(const LAS bf16x8*)(lds + ML_CBT + (128 + fr) * 272 + (32 * ks + 8 * fq) * 2);
                    a2 = __builtin_amdgcn_mfma_f32_16x16x32_bf16(af, bb, a2, 0, 0, 0); }
#pragma unroll
                for (int e = 0; e < 4; ++e) { const int t = 16 * tb + 4 * fq + e; dnum[e] = a1[e] + __expf(mprev - GA[64 + t]) * a2[e]; }
                if (fr == 0) {
#pragma unroll
                    for (int e = 0; e < 4; ++e) ((LAS float*)(lds + ML_DEN))[16 * tb + 4 * fq + e] = dnum[e];
                }
            }
        }
        LDS_BAR();
#pragma unroll
        for (int tb = 0; tb < 4; ++tb)
#pragma unroll
            for (int e = 0; e < 4; ++e) {
                const int t = 16 * tb + 4 * fq + e;
                const float dn = fmaxf(fabsf(((LAS float*)(lds + ML_DEN))[t]), __expf(-(GA[128 + t] + GA[64 + t])));
                const float hv = num[tb][e] * __builtin_amdgcn_rcpf(dn);
                const int row = rowbase + (dir == 0 ? t : 63 - t);
                HF[(size_t)row * 512 + h * 128 + 16 * w + fr] = (bf16_t)(pk2(hv, 0.f) & 0xffffu);
            }
#pragma unroll
        for (int vb = 0; vb < 9; ++vb) {
            u32x2 cw; cw.x = pk2(accC[vb][0], accC[vb][1]); cw.y = pk2(accC[vb][2], accC[vb][3]);
            *(LAS u32x2*)(lds + ML_CBT + (16 * vb + fr) * 272 + (16 * w + 4 * fq) * 2) = cw;
        }
        m = m_new;
    }
    __syncthreads();
#undef ML_ROWBASE
#undef ML_LOAD
}

__device__ void mix_phase(ArgsR a, int l, LAS unsigned char* lds, int slot, int nu_override) {
    unsigned* ctr = (unsigned*)(a.ws + WS_CTL) + slot + l;
    LAS int* su = (LAS int*)(lds + 131072);
    constexpr int NU = 128 + 2 * (1024 + 128);
    const int lim = nu_override ? nu_override : NU;
    const bool t0 = tidx() == 0;
    __syncthreads();
    if (t0) *su = (int)atomicAdd(ctr, 1u);
    __syncthreads();
    int u = *su;
    while (u < lim) {
        int nxt = 0;
        if (t0) nxt = (int)atomicAdd(ctr, 1u);
        if (u < 128) mlstm_unit(a, l, lds, u >> 3, (u >> 1) & 3, u & 1);
        else {
            int v = u - 128;
            int typeA = 0; if (v >= 1152) { typeA = 1; v -= 1152; }
            int isctx = 0, bb, kv, qb;
            if (v < 1024) { bb = v >> 6; kv = (v >> 5) & 1; qb = v & 31; } else { v -= 1024; isctx = 1; bb = v >> 3; kv = (v >> 2) & 1; qb = v & 3; }
            if (!(isctx && l == NL - 1)) attn_unit(a, l, lds, typeA, bb, kv, qb, isctx);
        }
        __syncthreads();
        if (t0) *su = nxt;
        __syncthreads();
        u = *su;
    }
}

__device__ void readout_phase(ArgsR a, int l) {
    const int tid = tidx(), lane = tid & 63, w = tid >> 6;
    const int gw = bidx() * 8 + w, NGW = gridDim.x * 8;
    const bf16_t* HF = (const bf16_t*)(a.ws + WS_HFB);
    const bf16_t* GS = (const bf16_t*)(a.ws + WS_RG0);
    bf16_t* YM = (bf16_t*)(a.ws + WS_Y3) + (size_t)2 * MT * 512;
    const float* hg = a.in[I_MNORM] + l * 512;
    float hgv[8];
#pragma unroll
    for (int e = 0; e < 8; ++e) hgv[e] = hg[8 * lane + e];
    const int rpw = (MT + NGW - 1) / NGW, m0 = gw * rpw, m1 = (m0 + rpw < MT) ? m0 + rpw : MT;
    if (m0 >= m1) return;
    u32x4 nf = *(const u32x4*)(HF + (size_t)m0 * 512 + 8 * lane), nb = *(const u32x4*)(HF + (size_t)MT * 512 + (size_t)m0 * 512 + 8 * lane), no = *(const u32x4*)(GS + (size_t)m0 * GSW + 8 * lane);
    for (int m = m0; m < m1; ++m) {
        const u32x4 cf = nf, cb = nb, co = no;
        if (m + 1 < m1) { nf = *(const u32x4*)(HF + (size_t)(m + 1) * 512 + 8 * lane); nb = *(const u32x4*)(HF + (size_t)MT * 512 + (size_t)(m + 1) * 512 + 8 * lane); no = *(const u32x4*)(GS + (size_t)(m + 1) * GSW + 8 * lane); }
        float f[8], bk[8], og[8];
        unpack8(cf, f); unpack8(cb, bk); unpack8(co, og);
        float ss = 0.f;
#pragma unroll
        for (int e = 0; e < 8; ++e) { f[e] += bk[e]; ss += f[e] * f[e]; }
        ss += __shfl_xor(ss, 1); ss += __shfl_xor(ss, 2); ss += __shfl_xor(ss, 4); ss += __shfl_xor(ss, 8);
        const float rms = 1.f / sqrtf(ss * (1.f / 128.f) + EPS);
#pragma unroll
        for (int e = 0; e < 8; ++e) f[e] = og[e] * (f[e] * rms * hgv[e]);
        *(u32x4*)(YM + (size_t)m * 512 + 8 * lane) = pack8(f);
    }
}

#define XB_TMO      128
#define XB_XCNT(j)  (256  + 64 * (j))
#define XB_XSUB(j)  (1280 + 64 * (j))
#define XB_XGEN(j)  (2304 + 64 * (j))
#define XB_TOP      3328
#define XB_TOPGEN   3392
#define XCD_BAR_WORDS 3456
#define XB_SPIN_CAP (1u << 20)
__device__ __forceinline__ unsigned xb_ld(unsigned* p)              { return __hip_atomic_load(p, __ATOMIC_RELAXED, __HIP_MEMORY_SCOPE_AGENT); }
__device__ __forceinline__ unsigned xb_add(unsigned* p, unsigned v) { return __hip_atomic_fetch_add(p, v, __ATOMIC_RELAXED, __HIP_MEMORY_SCOPE_AGENT); }
__device__ __forceinline__ unsigned xb_xcc_id() { return (unsigned)__builtin_amdgcn_s_getreg((3 << 11) | 20) & 0xFu; }
#define XB_SPIN(cond, bar) do { unsigned _sp = 0; while (cond) { __builtin_amdgcn_s_sleep(1); \
    if ((++_sp & 255u) == 0u) { if (xb_ld(&(bar)[XB_TMO])) break; if (_sp > XB_SPIN_CAP) { atomicAdd(&(bar)[XB_TMO], 1u); break; } } } } while (0)
__device__ __forceinline__ void xcd_barrier_complete(unsigned* bar, unsigned x, unsigned& nloc, unsigned& nx) {
    const unsigned G = gridDim.x;
    unsigned sum, cnt, mine, sp = 0u;
    for (;;) {
        sum = 0u; cnt = 0u; mine = 0u;
#pragma unroll
        for (unsigned j = 0; j < 16; ++j) { const unsigned c = xb_ld(&bar[XB_XCNT(j)]); sum += c; cnt += (c > 0u) ? 1u : 0u; mine = (j == x) ? c : mine; }
        if (sum == G) break;
        __builtin_amdgcn_s_sleep(1);
        if ((++sp & 255u) == 0u) { if (xb_ld(&bar[XB_TMO])) break; if (sp > XB_SPIN_CAP) { atomicAdd(&bar[XB_TMO], 1u); break; } }
    }
    nloc = mine > 0u ? mine : 1u; nx = cnt > 0u ? cnt : 1u;
}
__device__ __forceinline__ void xcd_barrier(unsigned* bar, unsigned x, volatile LAS unsigned* st) {
    asm volatile("s_waitcnt vmcnt(0)" ::: "memory");
    __syncthreads();
    if (threadIdx.x == 0) {
        __builtin_amdgcn_s_waitcnt(0);
        unsigned nloc = st[0], nx = st[1];
        if (nloc == 0u) { xcd_barrier_complete(bar, x, nloc, nx); st[0] = nloc; st[1] = nx; }
        const unsigned old = xb_add(&bar[XB_XSUB(x)], 1u);
        const unsigned gen = old / nloc;
        if (old + 1u == (gen + 1u) * nloc) {
            __builtin_amdgcn_fence(__ATOMIC_RELEASE, "agent");
            asm volatile("s_waitcnt vmcnt(0)" ::: "memory");
            const unsigned og = xb_add(&bar[XB_TOP], 1u);
            const unsigned tg = og / nx;
            if (og + 1u == (tg + 1u) * nx) xb_add(&bar[XB_TOPGEN], 1u);
            else XB_SPIN(xb_ld(&bar[XB_TOPGEN]) == tg, bar);
            __builtin_amdgcn_fence(__ATOMIC_ACQUIRE, "agent");
            xb_add(&bar[XB_XGEN(x)], 1u);
            asm volatile("s_waitcnt vmcnt(0)" ::: "memory");
        } else {
            XB_SPIN(xb_ld(&bar[XB_XGEN(x)]) == gen, bar);
            __builtin_amdgcn_fence(__ATOMIC_ACQUIRE, "agent");
            asm volatile("s_waitcnt vmcnt(0)" ::: "memory");
        }
    }
    __syncthreads();
}

__global__ void __launch_bounds__(512, 2) mk_fwd(Args a_kernarg) {
    extern __shared__ __attribute__((aligned(16))) unsigned char lds_raw[];
    LAS unsigned char* lds = (LAS unsigned char*)lds_raw;
    const int G = gridDim.x;
    const __attribute__((address_space(4))) Args* ap = (const __attribute__((address_space(4))) Args*)__builtin_amdgcn_kernarg_segment_ptr();
    const int ph_lo = ap->ph_lo, ph_hi = ap->ph_hi;
    volatile LAS unsigned* xb_st = (volatile LAS unsigned*)(lds + 131072 + 64);
    if (threadIdx.x == 0) { xb_st[0] = 0u; xb_st[1] = 0u; }
    const unsigned xb_x = xb_xcc_id();
    if (ph_hi - ph_lo > 1 && threadIdx.x == 0) (void)xb_add((unsigned*)(ap->ws + WS_BAR) + XB_XCNT(xb_x), 1u);
    __syncthreads();
    for (int ph = ph_lo; ph < ph_hi; ++ph) {
        asm volatile("" : "+s"(ap));
        ArgsR a = *ap;
        bf16_t* W = (bf16_t*)(a.ws + WS_W);
        bf16_t* HN = (bf16_t*)(a.ws + WS_HN);
        bf16_t* RG0 = (bf16_t*)(a.ws + WS_RG0);
        bf16_t* Y3 = (bf16_t*)(a.ws + WS_Y3);
        bf16_t* U = (bf16_t*)(a.ws + WS_HFB);
        bf16_t* YB = (bf16_t*)(a.ws + WS_QK);
        float* GMp = (float*)(a.ws + WS_GM);
        bool do_gemm = false, do_row = false;
        pg8::Gemm g{}; pg8::Order S{}; pg8::Epi E{}; RowP rp{};
        int l = 0, s = -1;
        if (ph == 0) {
            ;
        } else if (ph == 1) {
            rp = RowP{1, 0, 1, 0, 0, 0, 0, 0.f, MT, 0}; do_row = true;
        } else {
            l = (ph - 2) / 14; s = (ph - 2) - 14 * l;
            switch (s) {
            case 0: case 11:
                g = pg8::Gemm{HN, W + (s == 0 ? W_GU1 : W_GU2), MT, 5632, 1024, 0, 0}; S.init(MT, 5632, 1024, G, bidx(), 1, 0);
                E = pg8::Epi{1, RG0, FF, nullptr, -1, nullptr, nullptr, nullptr}; do_gemm = true; break;
            case 1: case 12: case 9:
                g = pg8::Gemm{s == 9 ? U : RG0, W + (s == 1 ? W_D1 : (s == 12 ? W_D2 : W_O)), MT, 1024, s == 9 ? 1024 : FF, 0, 0}; S.init(MT, 1024, g.K, G, bidx(), 1, (G == 256 && !(l == NL - 1 && s != 1)) ? TC / 256 : 0);
                E = pg8::Epi{0, YB, 1024, nullptr, -1, nullptr, nullptr, (bf16_t*)(a.ws + WS_END)}; do_gemm = true; break;
            case 3:
                g = pg8::Gemm{HN, W + W_INA, MT, PA, 1024, 0, 0}; S.init(MT, PA, 1024, G, bidx(), 1, 0);
                E = pg8::Epi{0, RG0, PA, GMp, 12, nullptr, a.in[I_QKN] + l * 128, nullptr}; do_gemm = true; break;
            case 6:
                g = pg8::Gemm{HN, W + W_INB, MT, GSW, 1024, 0, 0}; S.init(MT, GSW, 1024, G, bidx(), 1, 0);
                E = pg8::Epi{2, RG0, GSW, nullptr, -1, nullptr, nullptr, nullptr}; do_gemm = true; break;
            case 8:
                g = pg8::Gemm{Y3, W + W_B, MT, 1024, 512, (size_t)MT * 512 * 2, (size_t)1024 * 512 * 2}; S.init(MT, 1024, 512, G, bidx(), 3, 0);
                E = pg8::Epi{3, U, 1024, nullptr, -1, RG0, nullptr, nullptr}; do_gemm = true; break;
            case 2: rp = RowP{l == 0 ? 1 : 0, 1, 1, l, 0, l, 1, 0.5f, MT, G == 256}; do_row = true; break;
            case 10: rp = RowP{0, 1, 1, l, 1, l, 2, 1.0f, l == NL - 1 ? TL : MT, G == 256 && l != NL - 1}; do_row = true; break;
            case 13: rp = RowP{0, 1, l + 1 < NL ? 1 : 0, l, 2, l + 1, 0, 0.5f, l == NL - 1 ? TL : MT, G == 256 && l != NL - 1}; do_row = true; break;
            case 4: prep_phase(a, l, 2); break;
            case 5: { int nrep = PROBE_MIX_REPS; asm volatile("" : "+s"(nrep)); for (int rep = 0; rep < nrep; ++rep) mix_phase(a, l, lds, 16 + 16 * rep, rep ? 128 : 0); break; }
            case 7: readout_phase(a, l); break;
            }
        }
        if (do_gemm && l == NL - 1 && s >= 6) { g.M = TL; S.init(TL, g.N, g.K, G, bidx(), S.nz, 0); }
        if (do_gemm) {
            if (s == 8) pg8::gemm_phase<true>(lds, g, S, E); else pg8::gemm_phase<false>(lds, g, S, E);
        }
        if (do_row) row_phase(a, rp);
        {
            int cv_l = -1, lo1 = 0, hi1 = 0, lo2 = 0, hi2 = 0, wk = bidx(), nwk = G, pad = 0;
            if (ph == 0) { cv_l = 0; hi1 = 6544; pad = 1; }
            else if (ph >= 2) {
                const int l2 = (ph - 2) / 14, s2 = (ph - 2) - 14 * l2;
                if (l2 + 1 < NL) {
                    if (s2 == 13) { cv_l = l2 + 1; hi1 = 6544; pad = 1; }
                }
            }
            if (cv_l >= 0) convert_weights(a, cv_l, lds, lo1, hi1, lo2, hi2, wk, nwk, pad);
        }
        if (ph == 0) compute_mod(a, lds);
        if (ph + 1 < ph_hi) { if (ph_hi > NPH) cg::this_grid().sync();   else xcd_barrier((unsigned*)(a.ws + WS_BAR), xb_x, xb_st); }
    }
}

extern "C" void kernel_launch(void* const* d_in, const int* in_sizes, int n_in, void* d_out, int out_size, void* d_ws, size_t ws_size, hipStream_t stream) {
    static int grid = 0;
    if (grid == 0) {
        if (n_in != 19 || ws_size < WS_SCN + (size_t)MT * 8 * 16 || out_size != TL * DM) { fprintf(stderr, "kernel_launch: unexpected shapes (n_in %d, ws %zu, out %d)\n", n_in, ws_size, out_size); grid = -1; return; }
        int dev = 0, cus = 0, per_cu = 0;
        hipGetDevice(&dev); hipDeviceGetAttribute(&cus, hipDeviceAttributeMultiprocessorCount, dev);
        hipFuncSetAttribute((const void*)mk_fwd, hipFuncAttributeMaxDynamicSharedMemorySize, LDS_BYTES);
        hipOccupancyMaxActiveBlocksPerMultiprocessor(&per_cu, (const void*)mk_fwd, 512, LDS_BYTES);
        if (per_cu < 1) per_cu = 1;
        (void)hipGetLastError();
        grid = cus * per_cu;
    }
    if (grid < 0) return;
    (void)hipMemsetAsync((char*)d_ws + WS_CTL, 0, 4096 + 16384, stream);
    Args a{};
    for (int i = 0; i < 19; ++i) a.in[i] = (const float*)d_in[i];
    a.out = (float*)d_out; a.ws = (unsigned char*)d_ws;
#if MK_MULTI
    for (int ph = 0; ph < NPH; ++ph) {
        a.ph_lo = ph; a.ph_hi = ph + 1;
        hipLaunchKernelGGL(mk_fwd, dim3(grid), dim3(512), LDS_BYTES, stream, a);
    }
#else
    a.ph_lo = 0; a.ph_hi = NPH;
    void* args[] = {&a};
    hipError_t e = hipLaunchCooperativeKernel((const void*)mk_fwd, dim3(grid), dim3(512), args, LDS_BYTES, stream);
    if (e != hipSuccess) fprintf(stderr, "cooperative launch failed: %s (grid %d)\n", hipGetErrorString(e), grid);
#endif
}
```

```cpp
#include <hip/hip_runtime.h>
#include <hip/hip_cooperative_groups.h>
#include <cstdio>
#include <cstdint>
namespace cg = cooperative_groups;

#ifndef MK_MULTI
#define MK_MULTI 0
#endif

#ifndef PROBE_GEMM_REPS
#define PROBE_GEMM_REPS 1
#endif
#ifndef PROBE_SYNC_REPS
#define PROBE_SYNC_REPS 1
#endif
#ifndef PROBE_MIX_REPS
#define PROBE_MIX_REPS 1
#endif
#define LAS __attribute__((address_space(3)))
typedef unsigned short bf16_t;
typedef short bf16x8 __attribute__((ext_vector_type(8)));
typedef short s16x4 __attribute__((ext_vector_type(4)));
typedef float f32x2 __attribute__((ext_vector_type(2)));
typedef float f32x4 __attribute__((ext_vector_type(4)));
typedef float f32x16 __attribute__((ext_vector_type(16)));
typedef unsigned u32x4 __attribute__((ext_vector_type(4)));
typedef unsigned u32x2 __attribute__((ext_vector_type(2)));

constexpr int TL = 32768, TC = 4096, MT = TL + TC, DM = 1024, FF = 2816, NL = 4;
constexpr int SEQ = 2048, CTXL = 256, NB = 16;
constexpr int PA = 3328;
constexpr int GSW = 3584;
constexpr int INW = 6672;
constexpr float EPS = 1e-6f;
constexpr int NPH = 2 + 14 * NL;
constexpr int LDS_BYTES = 147456;

constexpr size_t MiB = 1u << 20;
constexpr size_t WS_CTL = 0;
constexpr size_t WS_BAR = 4096;
constexpr size_t WS_MOD = 4096 + 16384;
constexpr size_t WS_GM = WS_MOD + (size_t)NL * 17 * 9216 * 4;
constexpr size_t WS_W = 8 * MiB;
constexpr size_t WS_XC = 64 * MiB;
constexpr size_t WS_HN = 80 * MiB;
constexpr size_t WS_RG0 = 152 * MiB;
constexpr size_t WS_Y3 = 404 * MiB;
constexpr size_t WS_HFB = 512 * MiB;
constexpr size_t WS_QK = 584 * MiB;
constexpr size_t WS_END = 656 * MiB;
constexpr size_t WS_SCN = WS_END + 24 * MiB;
static_assert(WS_GM + (size_t)MT * 16 * 4 <= WS_W, "ws map");
constexpr size_t W_GU1 = 0, W_D1 = W_GU1 + (size_t)5632 * 1024, W_GU2 = W_D1 + (size_t)1024 * 2816, W_D2 = W_GU2 + (size_t)5632 * 1024;
constexpr size_t W_INA = W_D2 + (size_t)1024 * 2816, W_INB = W_INA + (size_t)PA * 1024, W_B = W_INB + (size_t)GSW * 1024, W_O = W_B + (size_t)3 * 1024 * 512, W_END = W_O + (size_t)1024 * 1024;
static_assert(WS_W + W_END * 2 <= WS_XC, "weights fit");

__device__ __forceinline__ int tidx() { int t = threadIdx.x; asm volatile("" : "+v"(t)); return t; }
__device__ __forceinline__ int bidx() { int t = blockIdx.x; asm volatile("" : "+s"(t)); return t; }
__device__ __forceinline__ float bf2f(unsigned short u) { return __builtin_bit_cast(float, (unsigned)u << 16); }
__device__ __forceinline__ unsigned pk2(float lo, float hi) { unsigned r; asm volatile("v_cvt_pk_bf16_f32 %0, %1, %2" : "=v"(r) : "v"(lo), "v"(hi)); return r; }
__device__ __forceinline__ float wave_sum(float v) {
#pragma unroll
    for (int o = 1; o < 64; o <<= 1) v += __shfl_xor(v, o);
    return v;
}
__device__ __forceinline__ float max3f_(float a, float b, float c) { float r; asm("v_max3_f32 %0, %1, %2, %3" : "=v"(r) : "v"(a), "v"(b), "v"(c)); return r; }
#define LDS_BAR() asm volatile("s_waitcnt lgkmcnt(0)\n\ts_barrier" ::: "memory")
__device__ __forceinline__ float sigmoidf_(float x) { return __builtin_amdgcn_rcpf(1.f + __builtin_amdgcn_exp2f(-1.4426950408889634f * x)); }
__device__ __forceinline__ float siluf_(float x) { return x * __builtin_amdgcn_rcpf(1.f + __builtin_amdgcn_exp2f(-1.4426950408889634f * x)); }
__device__ __forceinline__ void unpack8(u32x4 w, float* f) {
    f[0] = __builtin_bit_cast(float, w.x << 16); f[1] = __builtin_bit_cast(float, w.x & 0xffff0000u);
    f[2] = __builtin_bit_cast(float, w.y << 16); f[3] = __builtin_bit_cast(float, w.y & 0xffff0000u);
    f[4] = __builtin_bit_cast(float, w.z << 16); f[5] = __builtin_bit_cast(float, w.z & 0xffff0000u);
    f[6] = __builtin_bit_cast(float, w.w << 16); f[7] = __builtin_bit_cast(float, w.w & 0xffff0000u);
}
__device__ __forceinline__ u32x4 pack8(const float* f) { u32x4 w; w.x = pk2(f[0], f[1]); w.y = pk2(f[2], f[3]); w.z = pk2(f[4], f[5]); w.w = pk2(f[6], f[7]); return w; }

namespace pg8 {
constexpr int BM = 256, BK = 64, HALF = 128, HTB = HALF * BK * 2, NXCD = 8, WGM = 8;
__host__ __device__ __forceinline__ int lds_byte(int r, int c) { const int st = (r >> 4) * 2 + (c >> 5), rr = r & 15, cc = c & 31, ob = rr * 64 + cc * 2; return st * 1024 + (ob ^ (((ob >> 9) & 1) << 5)); }
__host__ __device__ __forceinline__ void stage_rc(int b, int& R, int& C) { const int st = b / 1024, sb = b % 1024, swz = sb ^ (((sb >> 9) & 1) << 5); R = (st >> 1) * 16 + swz / 64; C = (st & 1) * 32 + (swz % 64) / 2; }
__host__ __device__ __forceinline__ int perm32(int rho) { const int n = rho >> 4, i = rho & 15; return 8 * (i >> 2) + 4 * n + (i & 3); }

struct Unit { int pm, pn, z, k0, nt, part; };
struct Gemm { const bf16_t* A; const bf16_t* Bt; int M, N, K; size_t zA, zB; };

struct Order {
    int nM, nN, nwg, G, c, nz, ktiles, nsplit_tiles;
    __device__ void init(int M, int N, int K, int G_, int c_, int nz_, int split_mtiles) {
        nM = M / BM - split_mtiles; nN = N / BM; nwg = nM * nN; G = G_; c = c_; nz = nz_; ktiles = K / BK; nsplit_tiles = split_mtiles; }
    __device__ bool next(int i, Unit& u) const {
        const int ii = i / nz; u.z = i - ii * nz;
        const long L = (long)ii * G + c;
        u.k0 = 0; u.nt = ktiles; u.part = 0;
        if (L >= nwg) {
            const int q = (int)(L - nwg); if (q >= nsplit_tiles * nN * 4) return false;
            const int kp = q & 3, tile = q >> 2;
            u.pm = nM + tile / nN; u.pn = tile % nN; u.part = kp;
            const int base = (ktiles / 4) & ~1, extra = (ktiles - 4 * base) / 2;
            u.nt = base + (kp < extra ? 2 : 0); u.k0 = kp * base + 2 * (kp < extra ? kp : extra);
            return true;
        }
        int wgid = (int)L; { const int q = nwg / NXCD, r = nwg % NXCD, xcd = wgid % NXCD, off = wgid / NXCD; wgid = (xcd < r ? xcd * (q + 1) : r * (q + 1) + (xcd - r) * q) + off; }
        const int nig = WGM * nN, gid = wgid / nig, fm = gid * WGM, gsz = (nM - fm) < WGM ? (nM - fm) : WGM;
        u.pm = fm + ((wgid % nig) % gsz); u.pn = (wgid % nig) / gsz; return true;
    }
};

struct Epi {
    int MODE; bf16_t* O; int ldc; float* gm; int gm_pn; const bf16_t* GS; const float* qkn; bf16_t* O2;
    __device__ __forceinline__ void operator()(const f32x4 (&acc)[2][2][4][2], const Unit& u, int wr, int wc, int fr, int fq) const {
        const int row0 = u.pm * BM + wr * 64 + fr;
        if (MODE == 1) {
            const int col0 = u.pn * 128 + wc * 32 + 8 * fq;
#pragma unroll
            for (int ai = 0; ai < 2; ++ai)
#pragma unroll
                for (int m = 0; m < 4; ++m) {
                    bf16_t* rowp = O + (size_t)(row0 + ai * HALF + m * 16) * ldc + col0;
                    float v[8];
#pragma unroll
                    for (int n = 0; n < 2; ++n)
#pragma unroll
                        for (int j = 0; j < 4; j += 2) {
                            const f32x2 g = (f32x2){acc[ai][0][m][n][j], acc[ai][0][m][n][j + 1]}, up = (f32x2){acc[ai][1][m][n][j], acc[ai][1][m][n][j + 1]};
                            const f32x2 e = g * (f32x2){-1.4426950408889634f, -1.4426950408889634f};
                            f32x2 d; d.x = __builtin_amdgcn_exp2f(e.x); d.y = __builtin_amdgcn_exp2f(e.y);
                            d = d + (f32x2){1.f, 1.f};
                            f32x2 r; r.x = __builtin_amdgcn_rcpf(d.x); r.y = __builtin_amdgcn_rcpf(d.y);
                            const f32x2 o2 = (g * up) * r;
                            v[4 * n + j] = o2.x; v[4 * n + j + 1] = o2.y;
                        }
                    *(u32x4*)rowp = pack8(v);
                    __builtin_amdgcn_sched_barrier(0);
                }
        } else if (MODE == 0 && gm != nullptr && u.pn < 6 && (wc < 2 || (u.pn != 2 && u.pn != 5))) {
            const int col0 = u.pn * BM + wc * 32 + 8 * fq;
            const int axis = fq >> 1, pb = 8 * (fq & 1);
            const bool isB = u.pn >= 3;
            const float* gn = qkn + ((u.pn == 5) ? 64 : 0) + axis * 32 + pb;
            constexpr float FRQ[8] = {1.f, 0.5623413251903491f, 0.31622776601683794f, 0.17782794100389228f, 0.1f, 0.05623413251903491f, 0.031622776601683794f, 0.017782794100389228f};
            const float fsc = (fq & 1) ? 0.01f : 1.f;
#pragma unroll
            for (int ai = 0; ai < 2; ++ai)
#pragma unroll
                for (int m = 0; m < 4; ++m) {
                    const int row = row0 + ai * HALF + m * 16;
                    float x1[8], x2[8];
#pragma unroll
                    for (int n = 0; n < 2; ++n)
#pragma unroll
                        for (int j = 0; j < 4; ++j) { x1[4 * n + j] = acc[ai][0][m][n][j]; x2[4 * n + j] = acc[ai][1][m][n][j]; }
                    if (isB) {
                        float ss = 0.f;
#pragma unroll
                        for (int e = 0; e < 8; ++e) ss += x1[e] * x1[e] + x2[e] * x2[e];
                        ss += __shfl_xor(ss, 16); ss += __shfl_xor(ss, 32);
                        const float rms = 1.f / sqrtf(ss * (1.f / 64.f) + EPS);
#pragma unroll
                        for (int e = 0; e < 8; ++e) { x1[e] = x1[e] * rms * gn[e]; x2[e] = x2[e] * rms * gn[16 + e]; }
                    }
                    if (row < TL) {
                        const int t = row & (SEQ - 1); const float pos = (float)(axis == 0 ? (t >> 6) : (t & 63)) * fsc;
#pragma unroll
                        for (int e = 0; e < 8; ++e) { const float ang = pos * FRQ[e]; const float c = __cosf(ang), sn = __sinf(ang);
                            const float o1 = x1[e] * c - x2[e] * sn, o2 = x2[e] * c + x1[e] * sn; x1[e] = o1; x2[e] = o2; }
                    }
                    *(u32x4*)(O + (size_t)row * ldc + col0) = pack8(x1);
                    *(u32x4*)(O + (size_t)row * ldc + col0 + HALF) = pack8(x2);
                    __builtin_amdgcn_sched_barrier(0);
                }
        } else {
            const int col0 = u.pn * BM + wc * 32 + 8 * fq;
#pragma unroll
            for (int ai = 0; ai < 2; ++ai)
#pragma unroll
                for (int m = 0; m < 4; ++m) {
                    const int row = row0 + ai * HALF + m * 16;
#pragma unroll
                    for (int bj = 0; bj < 2; ++bj) {
                        const int col = col0 + bj * HALF;
                        float v[8];
#pragma unroll
                        for (int n = 0; n < 2; ++n)
#pragma unroll
                            for (int j = 0; j < 4; ++j) v[4 * n + j] = acc[ai][bj][m][n][j];
                        if (MODE == 0) {
                            bf16_t* dst = u.part == 0 ? O + (size_t)row * ldc + col : O2 + ((size_t)(u.part - 1) * TC + (row - TL)) * 1024 + col;
                            *(u32x4*)dst = pack8(v);
                            if (gm != nullptr && u.pn == gm_pn && bj == 0 && wc == 0 && fq < 2) {
                                float* g = gm + (size_t)row * 16 + 8 * fq;
                                *(f32x4*)g = (f32x4){v[0], v[1], v[2], v[3]}; *(f32x4*)(g + 4) = (f32x4){v[4], v[5], v[6], v[7]};
                            }
                        } else if (MODE == 2) {
#pragma unroll
                            for (int e = 0; e < 8; ++e) v[e] = sigmoidf_(v[e]);
                            *(u32x4*)(O + (size_t)row * ldc + col) = pack8(v);
                        } else {
                            float g[8]; unpack8(*(const u32x4*)(GS + (size_t)row * GSW + 512 + u.z * 1024 + col), g);
                            bf16_t* up = O + (size_t)row * ldc + col;
                            if (u.z == 0) {
#pragma unroll
                                for (int e = 0; e < 8; ++e) v[e] *= g[e];
                            } else {
                                float o[8]; unpack8(*(const u32x4*)up, o);
#pragma unroll
                                for (int e = 0; e < 8; ++e) v[e] = o[e] + v[e] * g[e];
                            }
                            *(u32x4*)up = pack8(v);
                        }
                        __builtin_amdgcn_sched_barrier(0);
                    }
                }
        }
    }
    __device__ __forceinline__ bool merge3(f32x4 (&acc)[2][2][4][2], const Unit& u, int wr, int wc, int fr, int fq) const {
        const int row0 = u.pm * BM + wr * 64 + fr;
            const int col0 = u.pn * BM + wc * 32 + 8 * fq;
#pragma unroll
            for (int ai = 0; ai < 2; ++ai)
#pragma unroll
                for (int m = 0; m < 4; ++m) {
                    const int row = row0 + ai * HALF + m * 16;
                    u32x4 gv[2], hv[2];
#pragma unroll
                    for (int bj = 0; bj < 2; ++bj) {
                        gv[bj] = __builtin_nontemporal_load((const u32x4*)(GS + (size_t)row * GSW + 512 + u.z * 1024 + col0 + bj * HALF));
                        hv[bj] = __builtin_nontemporal_load((const u32x4*)(GS + (size_t)row * GSW + 512 + (u.z < 2 ? u.z + 1 : 2) * 1024 + col0 + bj * HALF));
                    }
#pragma unroll
                    for (int bj = 0; bj < 2; ++bj) {
                        float g[8], h[8]; unpack8(gv[bj], g); unpack8(hv[bj], h);
                        if (u.z < 2) {
#pragma unroll
                            for (int n = 0; n < 2; ++n)
#pragma unroll
                                for (int j = 0; j < 4; ++j) acc[ai][bj][m][n][j] *= g[4 * n + j] * __builtin_amdgcn_rcpf(fmaxf(h[4 * n + j], 1e-30f));
                        } else {
                            float v[8];
#pragma unroll
                            for (int n = 0; n < 2; ++n)
#pragma unroll
                                for (int j = 0; j < 4; ++j) v[4 * n + j] = acc[ai][bj][m][n][j] * g[4 * n + j];
                            *(u32x4*)(O + (size_t)row * ldc + col0 + bj * HALF) = pack8(v);
                        }
                    }
                    __builtin_amdgcn_sched_barrier(0);
                }
        return u.z < 2;
    }
};

template <bool KEEP3, class EpiT>
__device__ __forceinline__ void gemm_phase(LAS unsigned char* lds, const Gemm g, const Order& S, const EpiT& E) {
    const int tid_ = tidx();
    const int tid = tid_, wid = __builtin_amdgcn_readfirstlane(tid >> 6), lane = tid & 63, wr = wid >> 2, wc = wid & 3, fr = lane & 15, fq = lane >> 4;
    const int K = g.K;
    unsigned voffA[2], voffB[2];
#pragma unroll
    for (int i = 0; i < 2; ++i) { int R, C; stage_rc(tid * 16 + i * 8192, R, C); const int Rb = (R & ~31) + perm32(R & 31);
        voffA[i] = (unsigned)(R * K + C) * 2u; voffB[i] = (unsigned)(Rb * K + C) * 2u; }
    const size_t kstep = (size_t)(BK * 2);
    const size_t hstep = (size_t)HALF * K * 2;
    const size_t tstep = 2 * hstep;
    const unsigned ldsw = (unsigned)wid * 1024u;
    const int aoff = lds_byte(wr * 64 + fr, fq * 8), boff = lds_byte(wc * 32 + fr, fq * 8);
#define PG8_SA(b, h) (((b) * 2 + (h)) * HTB)
#define PG8_SB(b, h) ((4 + (b) * 2 + (h)) * HTB)
#define PG8_STAGE(bufoff, gbase, voff) do { _Pragma("unroll") for (int _i = 0; _i < 2; ++_i) \
        __builtin_amdgcn_global_load_lds((const unsigned*)((const char*)(gbase) + (voff)[_i]), (LAS unsigned*)(lds + (bufoff) + ldsw + _i * 8192), 16, 0, 0); } while (0)
#define PG8_LDA(dst, b, h) do { _Pragma("unroll") for (int m = 0; m < 4; ++m) _Pragma("unroll") for (int k = 0; k < 2; ++k) dst[m][k] = *(const LAS bf16x8*)(lds + PG8_SA(b, h) + aoff + m * 2048 + k * 1024); } while (0)
#define PG8_LDB(dst, b, h) do { _Pragma("unroll") for (int n = 0; n < 2; ++n) _Pragma("unroll") for (int k = 0; k < 2; ++k) dst[n][k] = *(const LAS bf16x8*)(lds + PG8_SB(b, h) + boff + n * 2048 + k * 1024); } while (0)
#define PG8_MMA(ai, bj, At, Bt) do { __builtin_amdgcn_s_setprio(1); _Pragma("unroll") for (int m = 0; m < 4; ++m) _Pragma("unroll") for (int n = 0; n < 2; ++n) _Pragma("unroll") for (int k = 0; k < 2; ++k) \
        acc[ai][bj][m][n] = __builtin_amdgcn_mfma_f32_16x16x32_bf16(Bt[n][k], At[m][k], acc[ai][bj][m][n], 0, 0, 0); __builtin_amdgcn_s_setprio(0); } while (0)
#define PG8_WAIT_V(n) asm volatile("s_waitcnt vmcnt(" #n ")" ::: "memory")
#define PG8_WAIT_L(n) asm volatile("s_waitcnt lgkmcnt(" #n ")" ::: "memory")
#define PG8_BAR __builtin_amdgcn_s_barrier()
#define PG8_SCHED __builtin_amdgcn_sched_barrier(0)
    Unit cur, nxt; int ui = 0;
    if (!S.next(0, cur)) return;
    f32x4 acc[2][2][4][2];
#pragma unroll
    for (int a = 0; a < 2; ++a)
#pragma unroll
        for (int b = 0; b < 2; ++b)
#pragma unroll
            for (int m = 0; m < 4; ++m)
#pragma unroll
                for (int n = 0; n < 2; ++n) acc[a][b][m][n] = (f32x4){0.f, 0.f, 0.f, 0.f};
    bf16x8 At[4][2], B0[2][2], B1[2][2];
    const char* cA = (const char*)g.A + (size_t)cur.z * g.zA + (size_t)cur.pm * tstep + (size_t)cur.k0 * kstep; const char* cB = (const char*)g.Bt + (size_t)cur.z * g.zB + (size_t)cur.pn * tstep + (size_t)cur.k0 * kstep;
    PG8_STAGE(PG8_SB(0, 0), cB, voffB); PG8_STAGE(PG8_SB(0, 1), cB + hstep, voffB); PG8_STAGE(PG8_SA(0, 0), cA, voffA); PG8_STAGE(PG8_SA(0, 1), cA + hstep, voffA);
    if (wr == 1) PG8_BAR;
    PG8_WAIT_V(2); PG8_BAR;
    PG8_STAGE(PG8_SB(1, 0), cB + kstep, voffB); PG8_STAGE(PG8_SA(1, 0), cA + kstep, voffA); PG8_STAGE(PG8_SB(1, 1), cB + hstep + kstep, voffB);
    PG8_WAIT_V(6); PG8_BAR;
    for (;;) {
        const bool has_next = S.next(ui + 1, nxt);
        const char* nA = has_next ? (const char*)g.A + (size_t)nxt.z * g.zA + (size_t)nxt.pm * tstep + (size_t)nxt.k0 * kstep : cA; const char* nB = has_next ? (const char*)g.Bt + (size_t)nxt.z * g.zB + (size_t)nxt.pn * tstep + (size_t)nxt.k0 * kstep : cB;
        const int nt = cur.nt;
        for (int t = 0; t < nt; t += 2) {
            const bool last = (t == nt - 2);
            const char* a1 = cA + (size_t)(t + 1) * kstep;
            const char* a2 = last ? nA : cA + (size_t)(t + 2) * kstep; const char* b2 = last ? nB : cB + (size_t)(t + 2) * kstep;
            const char* a3 = a2 + kstep; const char* b3 = b2 + kstep;
            PG8_LDB(B0, 0, 0); PG8_LDB(B1, 0, 1); PG8_SCHED; PG8_LDA(At, 0, 0); PG8_STAGE(PG8_SA(1, 1), a1 + hstep, voffA);
            PG8_WAIT_V(8); PG8_WAIT_L(0); PG8_BAR; PG8_MMA(0, 0, At, B0); PG8_MMA(0, 1, At, B1); PG8_BAR; PG8_SCHED;
            PG8_LDA(At, 0, 1); PG8_STAGE(PG8_SB(0, 0), b2, voffB); PG8_STAGE(PG8_SB(0, 1), b2 + hstep, voffB); PG8_STAGE(PG8_SA(0, 0), a2, voffA);
            PG8_WAIT_V(8); PG8_WAIT_L(0); PG8_BAR; PG8_MMA(1, 0, At, B0); PG8_MMA(1, 1, At, B1); PG8_BAR; PG8_SCHED;
            PG8_LDB(B0, 1, 0); PG8_LDB(B1, 1, 1); PG8_SCHED; PG8_LDA(At, 1, 0); PG8_STAGE(PG8_SA(0, 1), a2 + hstep, voffA);
            PG8_WAIT_V(8); PG8_WAIT_L(0); PG8_BAR; PG8_MMA(0, 0, At, B0); PG8_MMA(0, 1, At, B1); PG8_BAR; PG8_SCHED;
            PG8_LDA(At, 1, 1); PG8_STAGE(PG8_SB(1, 0), b3, voffB); PG8_STAGE(PG8_SB(1, 1), b3 + hstep, voffB); PG8_STAGE(PG8_SA(1, 0), a3, voffA);
            PG8_WAIT_V(8); PG8_WAIT_L(0); PG8_BAR; PG8_MMA(1, 0, At, B0); PG8_MMA(1, 1, At, B1); PG8_BAR; PG8_SCHED;
        }
        if (wr == 0) PG8_BAR;
        bool keep = false;
        if constexpr (KEEP3) keep = E.merge3(acc, cur, wr, wc, fr, fq); else E(acc, cur, wr, wc, fr, fq);
        if (!has_next) break;
        if (!keep) {
#pragma unroll
            for (int a = 0; a < 2; ++a)
#pragma unroll
                for (int b = 0; b < 2; ++b)
#pragma unroll
                    for (int m = 0; m < 4; ++m)
#pragma unroll
                        for (int n = 0; n < 2; ++n) acc[a][b][m][n] = (f32x4){0.f, 0.f, 0.f, 0.f};
        }
        cur = nxt; cA = nA; cB = nB; ++ui;
        if (wr == 1) PG8_BAR;
    }
    PG8_WAIT_V(0);
    PG8_BAR;
#undef PG8_SA
#undef PG8_SB
#undef PG8_STAGE
#undef PG8_LDA
#undef PG8_LDB
#undef PG8_MMA
#undef PG8_WAIT_V
#undef PG8_WAIT_L
#undef PG8_BAR
#undef PG8_SCHED
}
}

struct Args {
    const float* in[19];
    float* out; unsigned char* ws;
    int ph_lo, ph_hi;
};
typedef const __attribute__((address_space(4))) Args& ArgsR;
enum { I_X = 0, I_C, I_CTX, I_CCTX, I_WADA, I_BADA, I_NORMG, I_WG, I_WU, I_WD, I_WIN, I_SINK, I_QKN, I_CONVW, I_CONVB, I_GATEB, I_MNORM, I_WB, I_WO };

__device__ __forceinline__ bf16_t* wdst_row(bf16_t* W, int type, int sub, int n, int& K) {
    switch (type) {
    case 0: K = 1024; return W + (sub ? W_GU2 : W_GU1) + (size_t)((n >> 7) * 256 + (n & 127)) * 1024;
    case 1: K = 1024; return W + (sub ? W_GU2 : W_GU1) + (size_t)((n >> 7) * 256 + 128 + (n & 127)) * 1024;
    case 2: K = 2816; return W + (sub ? W_D2 : W_D1) + (size_t)n * 2816;
    case 3: K = 1024;
        if (n < 1536) {
            const int tb = n >= 768 ? 3 : 0, nn = n >= 768 ? n - 768 : n, d = nn & 63;
            int tile, w, qk = 1;
            if (nn < 512) { const int head = nn >> 6; tile = tb + (head >> 2); w = head & 3; }
            else if (nn < 640) { tile = tb + 2; w = (nn - 512) >> 6; }
            else { tile = tb + 2; w = 2 + ((nn - 640) >> 6); qk = 0; }
            const int sl = qk ? ((d >> 4) & 1) * 32 + (d >> 5) * 16 + (d & 15) : d;
            return W + W_INA + (size_t)(256 * tile + (sl >> 5) * 128 + 32 * w + (sl & 31)) * 1024;
        }
        if (n < 3072) return W + W_INA + (size_t)n * 1024;
        if (n < 3584) return W + W_INB + (size_t)(n - 3072) * 1024;
        if (n < 3600) return W + W_INA + (size_t)(3072 + n - 3584) * 1024;
        return W + W_INB + (size_t)(512 + n - 3600) * 1024;
    case 4: K = 512; return W + W_B + (size_t)sub * 1024 * 512 + (size_t)n * 512;
    default: K = 1024; return W + W_O + (size_t)n * 1024;
    }
}
__device__ void convert_weights(ArgsR a, int l, LAS unsigned char* lds, int lo1, int hi1, int lo2, int hi2, int wk, int nwk, int do_pad) {
    LAS float* s = (LAS float*)lds;
    bf16_t* W = (bf16_t*)(a.ws + WS_W);
    const int tid = tidx();
    constexpr int NT_FF = 16 * 44, NT_IN = 16 * 105, NT_B = 8 * 16, NT_O = 16 * 16;
    constexpr int NITEMS = 6 * NT_FF + NT_IN + 3 * NT_B + NT_O;
    const int n1 = hi1 - lo1, ntot = n1 + (hi2 - lo2);
    for (int ii = wk; ii < ntot; ii += nwk) {
        const int it = ii < n1 ? lo1 + ii : lo2 + (ii - n1);
        int r = it, type, sub = 0, K, N; const float* src;
        if (r < 4 * NT_FF) { const int q = r / NT_FF; r -= q * NT_FF; type = q & 1; sub = q >> 1; K = 1024; N = 2816;
            src = (type == 0 ? a.in[I_WG] : a.in[I_WU]) + ((size_t)l * 2 + sub) * 1024 * 2816; }
        else if ((r -= 4 * NT_FF) < 2 * NT_FF) { sub = r / NT_FF; r -= sub * NT_FF; type = 2; K = 2816; N = 1024; src = a.in[I_WD] + ((size_t)l * 2 + sub) * 2816 * 1024; }
        else if ((r -= 2 * NT_FF) < NT_IN) { type = 3; K = 1024; N = INW; src = a.in[I_WIN] + (size_t)l * 1024 * INW; }
        else if ((r -= NT_IN) < 3 * NT_B) { sub = r / NT_B; r -= sub * NT_B; type = 4; K = 512; N = 1024; src = a.in[I_WB] + ((size_t)l * 3 + sub) * 512 * 1024; }
        else { r -= 3 * NT_B; type = 5; K = 1024; N = 1024; src = a.in[I_WO] + (size_t)l * 1024 * 1024; }
        const int nkb = K / 64, nb = r / nkb, kb = r - nb * nkb, k0 = kb * 64, n0 = nb * 64;
        __syncthreads();
#pragma unroll
        for (int i = 0; i < 8; ++i) { const int kk = i * 8 + (tid >> 6), nn = tid & 63; s[kk * 65 + nn] = (n0 + nn < N) ? __builtin_nontemporal_load(src + (size_t)(k0 + kk) * N + n0 + nn) : 0.f; }
        __syncthreads();
        const int n = tid >> 3, c = tid & 7;
        if (n0 + n < N) {
            int Kd; bf16_t* d = wdst_row(W, type, sub, n0 + n, Kd);
            float v[8];
#pragma unroll
            for (int i = 0; i < 8; ++i) v[i] = s[(8 * c + i) * 65 + n];
            *(u32x4*)(d + k0 + 8 * c) = pack8(v);
        }
    }
    if (do_pad) for (int i = wk * 512 + tid; i < (PA - 3088) * 1024 / 8; i += nwk * 512) *(u32x4*)(W + W_INA + (size_t)3088 * 1024 + (size_t)i * 8) = (u32x4){0u, 0u, 0u, 0u};
    __syncthreads();
}

__device__ void compute_mod(ArgsR a, LAS unsigned char* lds) {
    LAS float* sc = (LAS float*)lds;
    LAS float* red = (LAS float*)(lds + 17 * 1024 * 4);
    const int tid = tidx(), lane = tid & 63, w = tid >> 6;
    float* MOD = (float*)(a.ws + WS_MOD);
    constexpr int NITEMS = NL * 144;
    if ((int)bidx() >= NITEMS) return;
    __syncthreads();
    for (int i = tid; i < 17 * 1024; i += 512) { const int r = i >> 10, k = i & 1023; const float v = r < 16 ? a.in[I_C][r * 1024 + k] : a.in[I_CCTX][k]; sc[i] = siluf_(v); }
    __syncthreads();
    for (int it = bidx(); it < NITEMS; it += gridDim.x) {
        const int l = it / 144, j0 = (it - l * 144) * 64;
        const float* wp = a.in[I_WADA] + (size_t)l * 1024 * 9216 + (size_t)(w * 128) * 9216 + j0 + lane;
        float acc[17];
#pragma unroll
        for (int r = 0; r < 17; ++r) acc[r] = 0.f;
        for (int k8 = 0; k8 < 128; k8 += 16) {
            float wv[16];
#pragma unroll
            for (int u = 0; u < 16; ++u) wv[u] = __builtin_nontemporal_load(wp + (size_t)(k8 + u) * 9216);
#pragma unroll
            for (int u = 0; u < 16; ++u)
#pragma unroll
                for (int r = 0; r < 17; ++r) acc[r] += sc[r * 1024 + w * 128 + k8 + u] * wv[u];
        }
#pragma unroll
        for (int r = 0; r < 17; ++r) red[(w * 17 + r) * 64 + lane] = acc[r];
        __syncthreads();
        for (int i = tid; i < 17 * 64; i += 512) { const int r = i >> 6, col = i & 63; float sacc = a.in[I_BADA][l * 9216 + j0 + col];
#pragma unroll
            for (int ww = 0; ww < 8; ++ww) sacc += red[(ww * 17 + r) * 64 + col];
            MOD[((size_t)l * 17 + r) * 9216 + j0 + col] = sacc; }
        __syncthreads();
    }
}

struct RowP { int init, has_res, has_next, l, kpost, lnext, knext; float w; int nrows; int ksplit; };
__device__ void row_phase(ArgsR a, const RowP p) {
    const int tid = tidx(), lane = tid & 63, w = tid >> 6;
    const int gw = bidx() * 8 + w, NGW = gridDim.x * 8;
    const float* MOD = (const float*)(a.ws + WS_MOD);
    float* xc = (float*)(a.ws + WS_XC);
    bf16_t* HN = (bf16_t*)(a.ws + WS_HN);
    const bf16_t* YB = (const bf16_t*)(a.ws + WS_QK);
    const float* ng = a.in[I_NORMG];
    const int NR = p.nrows, rpw = (NR + NGW - 1) / NGW, m0 = gw * rpw, m1 = (m0 + rpw < NR) ? m0 + rpw : NR;
    if (m0 >= m1) return;
    f32x4 gpost[4], gpre[4], gate[4], sh[4], scl[4];
#pragma unroll
    for (int j = 0; j < 4; ++j) {
        gpost[j] = p.has_res ? *(const f32x4*)(ng + ((size_t)p.l * 6 + 2 * p.kpost + 1) * 1024 + 4 * lane + 256 * j) : (f32x4){0.f, 0.f, 0.f, 0.f};
        gpre[j] = p.has_next ? *(const f32x4*)(ng + ((size_t)p.lnext * 6 + 2 * p.knext) * 1024 + 4 * lane + 256 * j) : (f32x4){0.f, 0.f, 0.f, 0.f};
        gate[j] = sh[j] = scl[j] = (f32x4){0.f, 0.f, 0.f, 0.f};
    }
    int r_cur = -1;
#define RP_XR(m) (p.init ? ((m) < TL ? a.in[I_X] + (size_t)(m) * 1024 : a.in[I_CTX] + (size_t)((m) - TL) * 1024) : ((m) < TL ? a.out + (size_t)(m) * 1024 : xc + (size_t)((m) - TL) * 1024))
    f32x4 vn[4]; u32x2 yn[4], yp[3][4];
#define RP_PART(m, pp, j) (__builtin_nontemporal_load((const u32x2*)((const bf16_t*)(a.ws + WS_END) + ((size_t)(pp) * TC + ((m) - TL)) * 1024 + 4 * lane + 256 * (j))))
#pragma unroll
    for (int pp = 0; pp < 3; ++pp)
#pragma unroll
        for (int j = 0; j < 4; ++j) yp[pp][j] = (u32x2){0u, 0u};
    {
        const float* xr = RP_XR(m0);
#pragma unroll
        for (int j = 0; j < 4; ++j) { vn[j] = __builtin_nontemporal_load((const f32x4*)(xr + 4 * lane + 256 * j)); yn[j] = p.has_res ? __builtin_nontemporal_load((const u32x2*)(YB + (size_t)m0 * 1024 + 4 * lane + 256 * j)) : (u32x2){0u, 0u}; }
        if (p.ksplit && m0 >= TL) {
#pragma unroll
            for (int pp = 0; pp < 3; ++pp)
#pragma unroll
                for (int j = 0; j < 4; ++j) yp[pp][j] = RP_PART(m0, pp, j);
        }
    }
    for (int m = m0; m < m1; ++m) {
        f32x4 v[4]; u32x2 yq[4], yq2[3][4];
#pragma unroll
        for (int j = 0; j < 4; ++j) { v[j] = vn[j]; yq[j] = yn[j]; yq2[0][j] = yp[0][j]; yq2[1][j] = yp[1][j]; yq2[2][j] = yp[2][j]; }
        if (m + 1 < m1) {
            const float* xr = RP_XR(m + 1);
#pragma unroll
            for (int j = 0; j < 4; ++j) { vn[j] = __builtin_nontemporal_load((const f32x4*)(xr + 4 * lane + 256 * j)); if (p.has_res) yn[j] = __builtin_nontemporal_load((const u32x2*)(YB + (size_t)(m + 1) * 1024 + 4 * lane + 256 * j)); }
            if (p.ksplit && m + 1 >= TL) {
#pragma unroll
                for (int pp = 0; pp < 3; ++pp)
#pragma unroll
                    for (int j = 0; j < 4; ++j) yp[pp][j] = RP_PART(m + 1, pp, j);
            }
        }
        const int r = m < TL ? (m >> 11) : 16;
        if (r != r_cur) {
            r_cur = r;
#pragma unroll
            for (int j = 0; j < 4; ++j) {
                if (p.has_res) gate[j] = *(const f32x4*)(MOD + (((size_t)p.l * 17 + r) * 9 + 3 * p.kpost + 2) * 1024 + 4 * lane + 256 * j) * p.w;
                if (p.has_next) { sh[j] = *(const f32x4*)(MOD + (((size_t)p.lnext * 17 + r) * 9 + 3 * p.knext) * 1024 + 4 * lane + 256 * j);
                    scl[j] = *(const f32x4*)(MOD + (((size_t)p.lnext * 17 + r) * 9 + 3 * p.knext + 1) * 1024 + 4 * lane + 256 * j) + 1.f; }
            }
        }
        float* xw = m < TL ? a.out + (size_t)m * 1024 : xc + (size_t)(m - TL) * 1024;
        if (p.has_res) {
            f32x4 y[4]; float ss = 0.f;
#pragma unroll
            for (int j = 0; j < 4; ++j) { const u32x2 q = yq[j];
                y[j] = (f32x4){__builtin_bit_cast(float, q.x << 16), __builtin_bit_cast(float, q.x & 0xffff0000u), __builtin_bit_cast(float, q.y << 16), __builtin_bit_cast(float, q.y & 0xffff0000u)};
                if (p.ksplit && m >= TL) {
#pragma unroll
                    for (int pp = 0; pp < 3; ++pp) { const u32x2 q2 = yq2[pp][j];
                        y[j] = y[j] + (f32x4){__builtin_bit_cast(float, q2.x << 16), __builtin_bit_cast(float, q2.x & 0xffff0000u), __builtin_bit_cast(float, q2.y << 16), __builtin_bit_cast(float, q2.y & 0xffff0000u)}; }
                }
                ss += (y[j].x * y[j].x + y[j].y * y[j].y) + (y[j].z * y[j].z + y[j].w * y[j].w); }
            const float rms = 1.f / sqrtf(wave_sum(ss) * (1.f / 1024.f) + EPS);
#pragma unroll
            for (int j = 0; j < 4; ++j) v[j] = v[j] + gate[j] * ((y[j] * rms) * gpost[j]);
        }
        if (p.has_res) {
#pragma unroll
            for (int j = 0; j < 4; ++j) __builtin_nontemporal_store(v[j], (f32x4*)(xw + 4 * lane + 256 * j));
        }
        if (p.has_next) {
            float ss = 0.f;
#pragma unroll
            for (int j = 0; j < 4; ++j) ss += (v[j].x * v[j].x + v[j].y * v[j].y) + (v[j].z * v[j].z + v[j].w * v[j].w);
            const float rms = 1.f / sqrtf(wave_sum(ss) * (1.f / 1024.f) + EPS);
#pragma unroll
            for (int j = 0; j < 4; ++j) { const f32x4 h = ((v[j] * rms) * gpre[j]) * scl[j] + sh[j];
                u32x2 o; o.x = pk2(h.x, h.y); o.y = pk2(h.z, h.w);
                *(u32x2*)(HN + (size_t)m * 1024 + 4 * lane + 256 * j) = o; }
        }
    }
#undef RP_XR
#undef RP_PART
}

__device__ void prep_phase(ArgsR a, int l, int parts) {
    bf16_t* P = (bf16_t*)(a.ws + WS_RG0);
    bf16_t* QK = (bf16_t*)(a.ws + WS_QK);
    const int gt = bidx() * 512 + tidx(), NT = gridDim.x * 512;
    const float* qkn = a.in[I_QKN] + l * 128;
    if (parts & 1) for (long i = gt; i < (long)MT * 160; i += NT) {
        const int row = (int)(i / 160), rem = (int)(i - (long)row * 160), hs = rem >> 3, j = rem & 7;
        int col; const float* gn = nullptr;
        if (hs < 8) col = 64 * hs; else if (hs < 10) col = 512 + 64 * (hs - 8); else if (hs < 18) { col = 768 + 64 * (hs - 10); gn = qkn; } else { col = 1280 + 64 * (hs - 18); gn = qkn + 64; }
        const int axis = j >> 2, p0 = (j & 3) * 4;
        bf16_t* base = P + (size_t)row * PA + col + axis * 32 + p0;
        const u32x2 r1 = *(const u32x2*)base, r2 = *(const u32x2*)(base + 16);
        float x1[4] = {__builtin_bit_cast(float, r1.x << 16), __builtin_bit_cast(float, r1.x & 0xffff0000u), __builtin_bit_cast(float, r1.y << 16), __builtin_bit_cast(float, r1.y & 0xffff0000u)};
        float x2[4] = {__builtin_bit_cast(float, r2.x << 16), __builtin_bit_cast(float, r2.x & 0xffff0000u), __builtin_bit_cast(float, r2.y << 16), __builtin_bit_cast(float, r2.y & 0xffff0000u)};
        if (gn) {
            float ss = 0.f;
#pragma unroll
            for (int e = 0; e < 4; ++e) ss += x1[e] * x1[e] + x2[e] * x2[e];
            ss += __shfl_xor(ss, 1); ss += __shfl_xor(ss, 2); ss += __shfl_xor(ss, 4);
            const float rms = 1.f / sqrtf(ss * (1.f / 64.f) + EPS);
#pragma unroll
            for (int e = 0; e < 4; ++e) { x1[e] = x1[e] * rms * gn[axis * 32 + p0 + e]; x2[e] = x2[e] * rms * gn[axis * 32 + 16 + p0 + e]; }
        }
        if (row < TL) {
            const int t = row & (SEQ - 1); const float pos = (float)(axis == 0 ? (t >> 6) : (t & 63));
#pragma unroll
            for (int e = 0; e < 4; ++e) {
                const float freq = exp2f(-(float)(p0 + e) * (13.287712379549449f / 16.f));
                const float ang = pos * freq; const float c = __cosf(ang), s = __sinf(ang);
                const float o1 = x1[e] * c - x2[e] * s, o2 = x2[e] * c + x1[e] * s; x1[e] = o1; x2[e] = o2;
            }
        }
        if (gn || row < TL) {
            u32x2 o1, o2; o1.x = pk2(x1[0], x1[1]); o1.y = pk2(x1[2], x1[3]); o2.x = pk2(x2[0], x2[1]); o2.y = pk2(x2[2], x2[3]);
            *(u32x2*)base = o1; *(u32x2*)(base + 16) = o2;
        }
    }
    if (parts & 2) {
        const float* cw = a.in[I_CONVW] + (size_t)l * 5 * 1024; const float* cb = a.in[I_CONVB] + (size_t)l * 1024;
        const int oct = gt & 127, run = gt >> 7, nruns = NT >> 7, c0 = oct * 8;
        const int rpr = (MT + nruns - 1) / nruns;
        const int r0 = run * rpr, r1 = (r0 + rpr < MT) ? r0 + rpr : MT;
        float wt[5][8], bs[8];
#pragma unroll
        for (int j = 0; j < 5; ++j)
#pragma unroll
            for (int e = 0; e < 8; ++e) wt[j][e] = cw[j * 1024 + c0 + e];
#pragma unroll
        for (int e = 0; e < 8; ++e) bs[e] = cb[c0 + e];
        const float scl = c0 < 512 ? 0.08838834764831845f : 1.f;
#define CV_LD(rr) (((rr) >= 0 && (rr) < MT) ? *(const u32x4*)(P + (size_t)(rr) * PA + 1536 + c0) : (u32x4){0u, 0u, 0u, 0u})
        if (r0 < r1) {
            u32x4 win[8], nxt[4];
#pragma unroll
            for (int j = 0; j < 8; ++j) win[j] = CV_LD(r0 - 2 + j);
            for (int base = r0; base < r1; base += 4) {
#pragma unroll
                for (int j = 0; j < 4; ++j) nxt[j] = CV_LD(base + 6 + j);
#pragma unroll
                for (int q = 0; q < 4; ++q) {
                    const int row = base + q;
                    if (row < r1) {
                        int t, len; if (row < TL) { t = row & (SEQ - 1); len = SEQ; } else { t = (row - TL) & (CTXL - 1); len = CTXL; }
                        float acc[8];
#pragma unroll
                        for (int e = 0; e < 8; ++e) acc[e] = bs[e];
#pragma unroll
                        for (int j = 0; j < 5; ++j) {
                            const int tt = t + j - 2;
                            if (tt >= 0 && tt < len) {
                                float x[8]; unpack8(win[q + j], x);
#pragma unroll
                                for (int e = 0; e < 8; ++e) acc[e] += wt[j][e] * x[e];
                            }
                        }
#pragma unroll
                        for (int e = 0; e < 8; ++e) acc[e] = siluf_(acc[e]) * scl;
                        *(u32x4*)(QK + (size_t)row * 1024 + c0) = pack8(acc);
                    }
                }
#pragma unroll
                for (int j = 0; j < 4; ++j) { win[j] = win[j + 4]; win[j + 4] = nxt[j]; }
            }
        }
#undef CV_LD
    }
    if (parts & 2) {
        const float* GM = (const float*)(a.ws + WS_GM);
        f32x4* SCN = (f32x4*)(a.ws + WS_SCN);
        const int lane = threadIdx.x & 63, gw = gt >> 6, NGW = NT >> 6;
        for (int it = gw; it < (MT / 64) * 8; it += NGW) {
            const int ch = it >> 3, dh = it & 7, dir = dh >> 2, h = dh & 3;
            const int row = ch * 64 + (dir == 0 ? lane : 63 - lane);
            const float iv = GM[(size_t)row * 16 + dir * 8 + h] + a.in[I_GATEB][l * 16 + dir * 8 + h];
            const float fv = GM[(size_t)row * 16 + dir * 8 + 4 + h] + a.in[I_GATEB][l * 16 + dir * 8 + 4 + h];
            const float lf = fminf(fv, 0.f) - log1pf(__expf(-fabsf(fv)));
            float bc = lf;
#pragma unroll
            for (int o2 = 1; o2 < 64; o2 <<= 1) { const float t = __shfl_up(bc, o2); if (lane >= o2) bc += t; }
            const float av = iv - bc;
            float pm = av;
#pragma unroll
            for (int o2 = 1; o2 < 64; o2 <<= 1) { const float t = __shfl_up(pm, o2); if (lane >= o2) pm = fmaxf(pm, t); }
            SCN[(size_t)row * 8 + dh] = (f32x4){av, pm, bc, 0.f};
        }
    }
}

__device__ __forceinline__ void attn_tile(LAS unsigned char* lds, const unsigned cb, const unsigned kf_off, const unsigned vf_off, const bf16x8 (&qf)[4], f32x16 (&o)[2], float& m_run, float& l_run,
                                          const int typeA, const int ti, const int jlo, const int tq, const int hh) {
    const float C2 = 0.125f * 1.4426950408889634f;
    f32x16 st[4];
    {
        bf16x8 kf[4][4];
#pragma unroll
        for (int ks = 0; ks < 4; ++ks)
#pragma unroll
            for (int kt = 0; kt < 4; ++kt) kf[ks][kt] = *(const LAS bf16x8*)(lds + cb + kf_off + kt * (32 * 144) + ks * 32);
#pragma unroll
        for (int kt = 0; kt < 4; ++kt)
#pragma unroll
            for (int e = 0; e < 16; ++e) st[kt][e] = 0.f;
        __builtin_amdgcn_sched_barrier(0);
#pragma unroll
        for (int ks = 0; ks < 4; ++ks)
#pragma unroll
            for (int kt = 0; kt < 4; ++kt) st[kt] = __builtin_amdgcn_mfma_f32_32x32x16_bf16(kf[ks][kt], qf[ks], st[kt], 0, 0, 0);
    }
    s16x4 vfa[4][2][2], vfb[4][2][2];
#pragma unroll
    for (int kt = 0; kt < 4; ++kt)
#pragma unroll
        for (int s2 = 0; s2 < 2; ++s2)
#pragma unroll
            for (int dt = 0; dt < 2; ++dt) {
                const unsigned va = (cb ? 24576u : 0u) + vf_off + (unsigned)((32 * kt + 16 * s2) * 192 + dt * 64);
                vfa[kt][s2][dt] = __builtin_bit_cast(s16x4, __builtin_amdgcn_ds_read_tr16_b64_v4i16((LAS s16x4*)(lds + va)));
                vfb[kt][s2][dt] = __builtin_bit_cast(s16x4, __builtin_amdgcn_ds_read_tr16_b64_v4i16((LAS s16x4*)(lds + va + 8 * 192)));
            }
    __builtin_amdgcn_sched_barrier(0);
    if (typeA && ti >= 2) {
        const int s0 = 128 * (jlo + ti - 2);
#pragma unroll
        for (int kt = 0; kt < 4; ++kt)
#pragma unroll
            for (int e = 0; e < 16; ++e) { const int s = s0 + 32 * kt + (e & 3) + 8 * (e >> 2) + 4 * hh; const int d = tq - s; if (d > 128 || d < -128) st[kt][e] = -INFINITY; }
    }
    float mx0 = fmaxf(st[0][0], st[1][0]), mx1 = fmaxf(st[2][0], st[3][0]);
#pragma unroll
    for (int e = 1; e < 16; ++e) { mx0 = max3f_(mx0, st[0][e], st[1][e]); mx1 = max3f_(mx1, st[2][e], st[3][e]); }
    float mx = fmaxf(mx0, mx1);
    { const auto rr = __builtin_amdgcn_permlane32_swap(__builtin_bit_cast(unsigned, mx), __builtin_bit_cast(unsigned, mx), false, false);
      mx = fmaxf(__builtin_bit_cast(float, rr[0]), __builtin_bit_cast(float, rr[1])); }
    const float m_new = fmaxf(m_run, mx * C2);
    const float alpha = __builtin_amdgcn_exp2f(m_run - m_new);
    m_run = m_new;
    f32x2 psa = (f32x2){0.f, 0.f}, psb = (f32x2){0.f, 0.f};
    const f32x2 c2v = (f32x2){C2, C2}, mnv = (f32x2){m_new, m_new};
#pragma unroll
    for (int kt = 0; kt < 4; kt += 2)
#pragma unroll
        for (int e = 0; e < 16; e += 2) {
            f32x2 va = (f32x2){st[kt][e], st[kt][e + 1]}, vb = (f32x2){st[kt + 1][e], st[kt + 1][e + 1]};
            va = va * c2v - mnv; vb = vb * c2v - mnv;
            va.x = __builtin_amdgcn_exp2f(va.x); va.y = __builtin_amdgcn_exp2f(va.y); vb.x = __builtin_amdgcn_exp2f(vb.x); vb.y = __builtin_amdgcn_exp2f(vb.y);
            psa += va; psb += vb;
            st[kt][e] = va.x; st[kt][e + 1] = va.y; st[kt + 1][e] = vb.x; st[kt + 1][e + 1] = vb.y;
        }
    const float ps0 = psa.x + psa.y, ps1 = psb.x + psb.y;
    l_run = l_run * alpha + (ps0 + ps1);
#pragma unroll
    for (int e = 0; e < 16; ++e) { o[0][e] *= alpha; o[1][e] *= alpha; }
#pragma unroll
    for (int kt = 0; kt < 4; ++kt)
#pragma unroll
        for (int s2 = 0; s2 < 2; ++s2) {
            u32x4 pw; pw.x = pk2(st[kt][8 * s2 + 0], st[kt][8 * s2 + 1]); pw.y = pk2(st[kt][8 * s2 + 2], st[kt][8 * s2 + 3]);
            pw.z = pk2(st[kt][8 * s2 + 4], st[kt][8 * s2 + 5]); pw.w = pk2(st[kt][8 * s2 + 6], st[kt][8 * s2 + 7]);
            const bf16x8 pf = __builtin_bit_cast(bf16x8, pw);
#pragma unroll
            for (int dt = 0; dt < 2; ++dt) {
                const s16x4 v0 = vfa[kt][s2][dt], v1 = vfb[kt][s2][dt];
                const bf16x8 vf = (bf16x8){v0[0], v0[1], v0[2], v0[3], v1[0], v1[1], v1[2], v1[3]};
                o[dt] = __builtin_amdgcn_mfma_f32_32x32x16_bf16(vf, pf, o[dt], 0, 0, 0);
            }
        }
}

__device__ void attn_unit(ArgsR a, int l, LAS unsigned char* lds, int typeA, int b, int kv, int qb, int isctx) {
    const bf16_t* P = (const bf16_t*)(a.ws + WS_RG0);
    bf16_t* Y = (bf16_t*)(a.ws + WS_Y3) + (typeA ? 0 : (size_t)MT * 512);
    const int tid_ = tidx();
    const int tid = tid_, lane = tid & 63, w = __builtin_amdgcn_readfirstlane(tid >> 6), r = lane & 31, hh = lane >> 5;
    const int tb256 = typeA ? 0 : 768;
    const int kcol = tb256 + 512 + 32 * kv, vcol = tb256 + 512 + 32 * (2 + kv);
    const int g = w >> 1, half = w & 1, head = kv * 4 + g;
    const int qrow0 = isctx ? TL + b * CTXL + qb * 64 : b * SEQ + qb * 64;
    const int qrow = qrow0 + 32 * half + r;
    const int tq = qb * 64 + 32 * half + r;
    bf16x8 qf[4];
#pragma unroll
    for (int ks = 0; ks < 4; ++ks) { const int c = 2 * ks + hh; qf[ks] = *(const bf16x8*)(P + (size_t)qrow * PA + tb256 + 256 * (head >> 2) + 32 * (head & 3) + (c >> 2) * 128 + (c & 3) * 8); }
    int jlo = 0, nlat = 0;
    if (!isctx) { if (typeA) { const int t0 = qb * 64; jlo = (t0 - 128) < 0 ? 0 : (t0 - 128) >> 7; int jhi = (t0 + 191) >> 7; if (jhi > 15) jhi = 15; nlat = jhi - jlo + 1; } else { jlo = 0; nlat = 16; } }
    const int ntiles = 2 + nlat;
    const float C2 = 0.125f * 1.4426950408889634f;
    f32x16 o[2];
#pragma unroll
    for (int e = 0; e < 16; ++e) { o[0][e] = 0.f; o[1][e] = 0.f; }
    float m_run = -INFINITY, l_run = 0.f;
    const int srow = tid >> 3, sch = tid & 7, scol = (sch >> 2) * 128 + (sch & 3) * 8;
    const unsigned st_off = (unsigned)(srow * 72 + sch * 8) * 2u;
    const int i16 = lane & 15, g16 = (lane >> 4) & 1;
    const unsigned kf_off = (unsigned)(r * 72 + 8 * hh) * 2u;
    const unsigned vf_off = 36864u + (unsigned)((4 * hh + (i16 >> 2)) * 96 + 16 * g16 + 4 * (i16 & 3)) * 2u;
    const unsigned sv_off = (unsigned)(srow * 96 + sch * 8) * 2u;
#define AT_BASE(t) ((t) < 2 ? TL + b * CTXL + 128 * (t) : b * SEQ + 128 * (jlo + (t) - 2))
#define AT_LOAD(t, kreg, vreg) do { const int _kb = AT_BASE(t); \
        kreg[0] = *(const u32x4*)(P + (size_t)(_kb + srow) * PA + kcol + scol); kreg[1] = *(const u32x4*)(P + (size_t)(_kb + 64 + srow) * PA + kcol + scol); \
        vreg[0] = *(const u32x4*)(P + (size_t)(_kb + srow) * PA + vcol + scol); vreg[1] = *(const u32x4*)(P + (size_t)(_kb + 64 + srow) * PA + vcol + scol); } while (0)
#define AT_STORE(bo, kreg, vreg) do { *(LAS u32x4*)(lds + (bo) + st_off) = kreg[0]; *(LAS u32x4*)(lds + (bo) + 9216 + st_off) = kreg[1]; \
        *(LAS u32x4*)(lds + 36864 + ((bo) ? 24576u : 0u) + sv_off) = vreg[0]; *(LAS u32x4*)(lds + 36864 + ((bo) ? 24576u : 0u) + 12288 + sv_off) = vreg[1]; } while (0)
    u32x4 kr0[2], vr0[2], kr1[2], vr1[2];
    AT_LOAD(0, kr0, vr0);
    __syncthreads();
    AT_STORE(0u, kr0, vr0);
    AT_LOAD(1, kr1, vr1);
    { const int tn = 2 < ntiles ? 2 : ntiles - 1; AT_LOAD(tn, kr0, vr0); }
    LDS_BAR();
    for (int ti = 0; ti < ntiles; ti += 2) {
        attn_tile(lds, 0u, kf_off, vf_off, qf, o, m_run, l_run, typeA, ti, jlo, tq, hh);
        AT_STORE(18432u, kr1, vr1);
        { const int tn = ti + 3 < ntiles ? ti + 3 : ntiles - 1; AT_LOAD(tn, kr1, vr1); }
        LDS_BAR();
        if (ti + 1 < ntiles) attn_tile(lds, 18432u, kf_off, vf_off, qf, o, m_run, l_run, typeA, ti + 1, jlo, tq, hh);
        AT_STORE(0u, kr0, vr0);
        { const int tn = ti + 4 < ntiles ? ti + 4 : ntiles - 1; AT_LOAD(tn, kr0, vr0); }
        LDS_BAR();
    }
#undef AT_BASE
#undef AT_LOAD
#undef AT_STORE
    float lt = l_run + __shfl_xor(l_run, 32);
    if (typeA) lt += exp2f(a.in[I_SINK][l * 8 + head] * 1.4426950408889634f - m_run);
    const float inv = 1.f / lt;
    bf16_t* yr = Y + (size_t)qrow * 512 + head * 64;
#pragma unroll
    for (int dt = 0; dt < 2; ++dt)
#pragma unroll
        for (int rg = 0; rg < 4; ++rg) {
            u32x2 ow; ow.x = pk2(o[dt][4 * rg] * inv, o[dt][4 * rg + 1] * inv); ow.y = pk2(o[dt][4 * rg + 2] * inv, o[dt][4 * rg + 3] * inv);
            *(u32x2*)(yr + 32 * dt + 8 * rg + 4 * hh) = ow;
        }
}

constexpr int ML_QS = 0, ML_KS = 17408, ML_KWT = 34816, ML_VT = 53248, ML_CBT = 73984, ML_SS = 113152, ML_GA = 122368, ML_DEN = 124416;
__device__ void mlstm_unit(ArgsR a, int l, LAS unsigned char* lds, int b, int h, int dir) {
    const bf16_t* P = (const bf16_t*)(a.ws + WS_RG0);
    const bf16_t* QK = (const bf16_t*)(a.ws + WS_QK);
    const f32x4* SCN = (const f32x4*)(a.ws + WS_SCN);
    bf16_t* HF = (bf16_t*)(a.ws + WS_HFB) + (size_t)dir * MT * 512;
    const int tid_ = tidx();
    const int tid = tid_, lane = tid & 63, w = __builtin_amdgcn_readfirstlane(tid >> 6), fr = lane & 15, fq = lane >> 4;
    __syncthreads();
    for (int i = tid; i < 39168 / 4; i += 512) ((LAS unsigned*)(lds + ML_CBT))[i] = 0u;
    for (int i = tid; i < 16 * 72; i += 512) { const int rr = i / 72, cc = i - rr * 72; ((LAS bf16_t*)(lds + ML_VT))[(128 + rr) * 72 + cc] = (rr == 0 && cc < 64) ? (bf16_t)0x3F80 : (bf16_t)0; }
    f32x4 accC[9];
#pragma unroll
    for (int v = 0; v < 9; ++v) accC[v] = (f32x4){0.f, 0.f, 0.f, 0.f};
    float m = 0.f;
    u32x4 qr[2], kr[2], vr[2]; f32x4 scn;
#define ML_ROWBASE(ci) ((ci) < 4 ? TL + b * CTXL + (dir == 0 ? (ci) : 3 - (ci)) * 64 : b * SEQ + (dir == 0 ? (ci) - 4 : 35 - (ci)) * 64)
#define ML_LOAD(ci) do { const int _row = ML_ROWBASE(ci) + (dir == 0 ? lane : 63 - lane); \
        _Pragma("unroll") for (int _o = 0; _o < 2; ++_o) { const int _oc = (w + 8 * _o) * 8; \
            qr[_o] = *(const u32x4*)(QK + (size_t)_row * 1024 + h * 128 + _oc); kr[_o] = *(const u32x4*)(QK + (size_t)_row * 1024 + 512 + h * 128 + _oc); \
            vr[_o] = *(const u32x4*)(P + (size_t)_row * PA + 2560 + h * 128 + _oc); } \
        scn = SCN[(size_t)_row * 8 + dir * 4 + h]; } while (0)
    ML_LOAD(0);
    for (int ci = 0; ci < 36; ++ci) {
        const int rowbase = ML_ROWBASE(ci);
        LAS float* GA = (LAS float*)(lds + ML_GA + (ci & 1) * 1024);
        const float av = scn.x, pm = scn.y, bc = scn.z;
        const float Mv = fmaxf(m, pm);
        const float M63 = __shfl(Mv, 63), b63 = __shfl(bc, 63);
        const float wend = __expf(av - M63);
        const float m_new = b63 + M63, decay = __expf(m - M63);
        if (w == 0) { GA[lane] = av; GA[64 + lane] = Mv; GA[128 + lane] = bc; if (lane == 0) GA[192] = m; }
#pragma unroll
        for (int o2 = 0; o2 < 2; ++o2) {
            const int oc = (w + 8 * o2) * 8;
            *(LAS u32x4*)(lds + ML_QS + lane * 272 + oc * 2) = qr[o2];
            *(LAS u32x4*)(lds + ML_KS + lane * 272 + oc * 2) = kr[o2];
            float kf[8]; unpack8(kr[o2], kf);
            const unsigned short* vs = (const unsigned short*)&vr[o2];
#pragma unroll
            for (int e = 0; e < 8; ++e) {
                ((LAS bf16_t*)(lds + ML_KWT))[(oc + e) * 72 + lane] = (bf16_t)(pk2(kf[e] * wend, 0.f) & 0xffffu);
                ((LAS bf16_t*)(lds + ML_VT))[(oc + e) * 72 + lane] = vs[e];
            }
        }
        LDS_BAR();
        if (ci + 1 < 36) ML_LOAD(ci + 1);
        {
            bf16x8 af[2];
#pragma unroll
            for (int ks = 0; ks < 2; ++ks) af[ks] = *(const LAS bf16x8*)(lds + ML_KWT + (16 * w + fr) * 144 + (32 * ks + 8 * fq) * 2);
#pragma unroll
            for (int vb = 0; vb < 9; ++vb) {
                accC[vb] = accC[vb] * decay;
#pragma unroll
                for (int ks = 0; ks < 2; ++ks) {
                    const bf16x8 bfv = *(const LAS bf16x8*)(lds + ML_VT + (16 * vb + fr) * 144 + (32 * ks + 8 * fq) * 2);
                    accC[vb] = __builtin_amdgcn_mfma_f32_16x16x32_bf16(af[ks], bfv, accC[vb], 0, 0, 0);
                }
            }
        }
        {
            const int tb = w >> 1;
            bf16x8 af[4];
#pragma unroll
            for (int ks = 0; ks < 4; ++ks) af[ks] = *(const LAS bf16x8*)(lds + ML_QS + (16 * tb + fr) * 272 + (32 * ks + 8 * fq) * 2);
#pragma unroll
            for (int si = 0; si < 2; ++si) {
                const int sb = 2 * (w & 1) + si;
                f32x4 acc = (f32x4){0.f, 0.f, 0.f, 0.f};
#pragma unroll
                for (int ks = 0; ks < 4; ++ks) {
                    const bf16x8 bfv = *(const LAS bf16x8*)(lds + ML_KS + (16 * sb + fr) * 272 + (32 * ks + 8 * fq) * 2);
                    acc = __builtin_amdgcn_mfma_f32_16x16x32_bf16(af[ks], bfv, acc, 0, 0, 0);
                }
                const int s = 16 * sb + fr; const float as = GA[s];
#pragma unroll
                for (int e = 0; e < 4; ++e) { const int t = 16 * tb + 4 * fq + e; const float val = (s <= t) ? acc[e] * __expf(as - GA[64 + t]) : 0.f;
                    ((LAS bf16_t*)(lds + ML_SS))[t * 72 + s] = (bf16_t)(pk2(val, 0.f) & 0xffffu); }
            }
        }
        LDS_BAR();
        f32x4 num[4]; f32x4 dnum = (f32x4){0.f, 0.f, 0.f, 0.f};
        const float mprev = GA[192];
        {
            bf16x8 bV[2], bC[4];
#pragma unroll
            for (int ks = 0; ks < 2; ++ks) bV[ks] = *(const LAS bf16x8*)(lds + ML_VT + (16 * w + fr) * 144 + (32 * ks + 8 * fq) * 2);
#pragma unroll
            for (int ks = 0; ks < 4; ++ks) bC[ks] = *(const LAS bf16x8*)(lds + ML_CBT + (16 * w + fr) * 272 + (32 * ks + 8 * fq) * 2);
#pragma unroll
            for (int tb = 0; tb < 4; ++tb) {
                f32x4 a1 = (f32x4){0.f, 0.f, 0.f, 0.f}, a2 = (f32x4){0.f, 0.f, 0.f, 0.f};
#pragma unroll
                for (int ks = 0; ks < 2; ++ks) { const bf16x8 af = *(const LAS bf16x8*)(lds + ML_SS + (16 * tb + fr) * 144 + (32 * ks + 8 * fq) * 2);
                    a1 = __builtin_amdgcn_mfma_f32_16x16x32_bf16(af, bV[ks], a1, 0, 0, 0); }
#pragma unroll
                for (int ks = 0; ks < 4; ++ks) { const bf16x8 af = *(const LAS bf16x8*)(lds + ML_QS + (16 * tb + fr) * 272 + (32 * ks + 8 * fq) * 2);
                    a2 = __builtin_amdgcn_mfma_f32_16x16x32_bf16(af, bC[ks], a2, 0, 0, 0); }
#pragma unroll
                for (int e = 0; e < 4; ++e) { const int t = 16 * tb + 4 * fq + e; num[tb][e] = a1[e] + __expf(mprev - GA[64 + t]) * a2[e]; }
            }
            if (w < 4) {
                const int tb = w;
                f32x4 a1 = (f32x4){0.f, 0.f, 0.f, 0.f}, a2 = (f32x4){0.f, 0.f, 0.f, 0.f};
#pragma unroll
                for (int ks = 0; ks < 2; ++ks) { const bf16x8 af = *(const LAS bf16x8*)(lds + ML_SS + (16 * tb + fr) * 144 + (32 * ks + 8 * fq) * 2);
                    const bf16x8 bb = *(const LAS bf16x8*)(lds + ML_VT + (128 + fr) * 144 + (32 * ks + 8 * fq) * 2);
                    a1 = __builtin_amdgcn_mfma_f32_16x16x32_bf16(af, bb, a1, 0, 0, 0); }
#pragma unroll
                for (int ks = 0; ks < 4; ++ks) { const bf16x8 af = *(const LAS bf16x8*)(lds + ML_QS + (16 * tb + fr) * 272 + (32 * ks + 8 * fq) * 2);
                    const bf16x8 bb = *(const LAS bf16x8*)(lds + ML_CBT + (128 + fr) * 272 + (32 * ks + 8 * fq) * 2);
                    a2 = __builtin_amdgcn_mfma_f32_16x16x32_bf16(af, bb, a2, 0, 0, 0); }
#pragma unroll
                for (int e = 0; e < 4; ++e) { const int t = 16 * tb + 4 * fq + e; dnum[e] = a1[e] + __expf(mprev - GA[64 + t]) * a2[e]; }
                if (fr == 0) {
#pragma unroll
                    for (int e = 0; e < 4; ++e) ((LAS float*)(lds + ML_DEN))[16 * tb + 4 * fq + e] = dnum[e];
                }
            }
        }
        LDS_BAR();
#pragma unroll
        for (int tb = 0; tb < 4; ++tb)
#pragma unroll
            for (int e = 0; e < 4; ++e) {
                const int t = 16 * tb + 4 * fq + e;
                const float dn = fmaxf(fabsf(((LAS float*)(lds + ML_DEN))[t]), __expf(-(GA[128 + t] + GA[64 + t])));
                const float hv = num[tb][e] * __builtin_amdgcn_rcpf(dn);
                const int row = rowbase + (dir == 0 ? t : 63 - t);
                __builtin_nontemporal_store((bf16_t)(pk2(hv, 0.f) & 0xffffu), HF + (size_t)row * 512 + h * 128 + 16 * w + fr);
            }
#pragma unroll
        for (int vb = 0; vb < 9; ++vb) {
            u32x2 cw; cw.x = pk2(accC[vb][0], accC[vb][1]); cw.y = pk2(accC[vb][2], accC[vb][3]);
            *(LAS u32x2*)(lds + ML_CBT + (16 * vb + fr) * 272 + (16 * w + 4 * fq) * 2) = cw;
        }
        m = m_new;
    }
    __syncthreads();
#undef ML_ROWBASE
#undef ML_LOAD
}

__device__ void mix_phase(ArgsR a, int l, LAS unsigned char* lds, int slot, int nu_override) {
    unsigned* ctr = (unsigned*)(a.ws + WS_CTL) + slot + l;
    LAS int* su = (LAS int*)(lds + 131072);
    constexpr int NU = 128 + 2 * (1024 + 128);
    for (;;) {
        __syncthreads();
        if (tidx() == 0) *su = (int)atomicAdd(ctr, 1u);
        __syncthreads();
        int u = *su;
        if (u >= (nu_override ? nu_override : NU)) break;
        if (u < 128) { mlstm_unit(a, l, lds, u >> 3, (u >> 1) & 3, u & 1); continue; }
        u -= 128;
        int typeA = 0; if (u >= 1152) { typeA = 1; u -= 1152; }
        int isctx = 0, bb, kv, qb;
        if (u < 1024) { bb = u >> 6; kv = (u >> 5) & 1; qb = u & 31; } else { u -= 1024; isctx = 1; bb = u >> 3; kv = (u >> 2) & 1; qb = u & 3; }
        attn_unit(a, l, lds, typeA, bb, kv, qb, isctx);
    }
}

__device__ void readout_phase(ArgsR a, int l) {
    const int tid = tidx(), lane = tid & 63, w = tid >> 6;
    const int gw = bidx() * 8 + w, NGW = gridDim.x * 8;
    const bf16_t* HF = (const bf16_t*)(a.ws + WS_HFB);
    const bf16_t* GS = (const bf16_t*)(a.ws + WS_RG0);
    bf16_t* YM = (bf16_t*)(a.ws + WS_Y3) + (size_t)2 * MT * 512;
    const float* hg = a.in[I_MNORM] + l * 512;
    float hgv[8];
#pragma unroll
    for (int e = 0; e < 8; ++e) hgv[e] = hg[8 * lane + e];
    const int rpw = (MT + NGW - 1) / NGW, m0 = gw * rpw, m1 = (m0 + rpw < MT) ? m0 + rpw : MT;
    if (m0 >= m1) return;
    u32x4 nf = *(const u32x4*)(HF + (size_t)m0 * 512 + 8 * lane), nb = *(const u32x4*)(HF + (size_t)MT * 512 + (size_t)m0 * 512 + 8 * lane), no = *(const u32x4*)(GS + (size_t)m0 * GSW + 8 * lane);
    for (int m = m0; m < m1; ++m) {
        const u32x4 cf = nf, cb = nb, co = no;
        if (m + 1 < m1) { nf = *(const u32x4*)(HF + (size_t)(m + 1) * 512 + 8 * lane); nb = *(const u32x4*)(HF + (size_t)MT * 512 + (size_t)(m + 1) * 512 + 8 * lane); no = *(const u32x4*)(GS + (size_t)(m + 1) * GSW + 8 * lane); }
        float f[8], bk[8], og[8];
        unpack8(cf, f); unpack8(cb, bk); unpack8(co, og);
        float ss = 0.f;
#pragma unroll
        for (int e = 0; e < 8; ++e) { f[e] += bk[e]; ss += f[e] * f[e]; }
        ss += __shfl_xor(ss, 1); ss += __shfl_xor(ss, 2); ss += __shfl_xor(ss, 4); ss += __shfl_xor(ss, 8);
        const float rms = 1.f / sqrtf(ss * (1.f / 128.f) + EPS);
#pragma unroll
        for (int e = 0; e < 8; ++e) f[e] = og[e] * (f[e] * rms * hgv[e]);
        *(u32x4*)(YM + (size_t)m * 512 + 8 * lane) = pack8(f);
    }
}

#define XB_TMO      128
#define XB_XCNT(j)  (256  + 64 * (j))
#define XB_XSUB(j)  (1280 + 64 * (j))
#define XB_XGEN(j)  (2304 + 64 * (j))
#define XB_TOP      3328
#define XB_TOPGEN   3392
#define XCD_BAR_WORDS 3456
#define XB_SPIN_CAP (1u << 20)
__device__ __forceinline__ unsigned xb_ld(unsigned* p)              { return __hip_atomic_load(p, __ATOMIC_RELAXED, __HIP_MEMORY_SCOPE_AGENT); }
__device__ __forceinline__ unsigned xb_add(unsigned* p, unsigned v) { return __hip_atomic_fetch_add(p, v, __ATOMIC_RELAXED, __HIP_MEMORY_SCOPE_AGENT); }
__device__ __forceinline__ unsigned xb_xcc_id() { return (unsigned)__builtin_amdgcn_s_getreg((3 << 11) | 20) & 0xFu; }
#define XB_SPIN(cond, bar) do { unsigned _sp = 0; while (cond) { __builtin_amdgcn_s_sleep(1); \
    if ((++_sp & 255u) == 0u) { if (xb_ld(&(bar)[XB_TMO])) break; if (_sp > XB_SPIN_CAP) { atomicAdd(&(bar)[XB_TMO], 1u); break; } } } } while (0)
__device__ __forceinline__ void xcd_barrier_complete(unsigned* bar, unsigned x, unsigned& nloc, unsigned& nx) {
    const unsigned G = gridDim.x;
    unsigned sum, cnt, mine, sp = 0u;
    for (;;) {
        sum = 0u; cnt = 0u; mine = 0u;
#pragma unroll
        for (unsigned j = 0; j < 16; ++j) { const unsigned c = xb_ld(&bar[XB_XCNT(j)]); sum += c; cnt += (c > 0u) ? 1u : 0u; mine = (j == x) ? c : mine; }
        if (sum == G) break;
        __builtin_amdgcn_s_sleep(1);
        if ((++sp & 255u) == 0u) { if (xb_ld(&bar[XB_TMO])) break; if (sp > XB_SPIN_CAP) { atomicAdd(&bar[XB_TMO], 1u); break; } }
    }
    nloc = mine > 0u ? mine : 1u; nx = cnt > 0u ? cnt : 1u;
}
__device__ __forceinline__ void xcd_barrier(unsigned* bar, unsigned x, volatile LAS unsigned* st) {
    asm volatile("s_waitcnt vmcnt(0)" ::: "memory");
    __syncthreads();
    if (threadIdx.x == 0) {
        __builtin_amdgcn_s_waitcnt(0);
        unsigned nloc = st[0], nx = st[1];
        if (nloc == 0u) { xcd_barrier_complete(bar, x, nloc, nx); st[0] = nloc; st[1] = nx; }
        const unsigned old = xb_add(&bar[XB_XSUB(x)], 1u);
        const unsigned gen = old / nloc;
        if (old + 1u == (gen + 1u) * nloc) {
            __builtin_amdgcn_fence(__ATOMIC_RELEASE, "agent");
            asm volatile("s_waitcnt vmcnt(0)" ::: "memory");
            const unsigned og = xb_add(&bar[XB_TOP], 1u);
            const unsigned tg = og / nx;
            if (og + 1u == (tg + 1u) * nx) xb_add(&bar[XB_TOPGEN], 1u);
            else XB_SPIN(xb_ld(&bar[XB_TOPGEN]) == tg, bar);
            __builtin_amdgcn_fence(__ATOMIC_ACQUIRE, "agent");
            xb_add(&bar[XB_XGEN(x)], 1u);
            asm volatile("s_waitcnt vmcnt(0)" ::: "memory");
        } else {
            XB_SPIN(xb_ld(&bar[XB_XGEN(x)]) == gen, bar);
            __builtin_amdgcn_fence(__ATOMIC_ACQUIRE, "agent");
            asm volatile("s_waitcnt vmcnt(0)" ::: "memory");
        }
    }
    __syncthreads();
}

__global__ void __launch_bounds__(512, 2) mk_fwd(Args a_kernarg) {
    extern __shared__ __attribute__((aligned(16))) unsigned char lds_raw[];
    LAS unsigned char* lds = (LAS unsigned char*)lds_raw;
    const int G = gridDim.x;
    const __attribute__((address_space(4))) Args* ap = (const __attribute__((address_space(4))) Args*)__builtin_amdgcn_kernarg_segment_ptr();
    const int ph_lo = ap->ph_lo, ph_hi = ap->ph_hi;
    volatile LAS unsigned* xb_st = (volatile LAS unsigned*)(lds + 131072 + 64);
    if (threadIdx.x == 0) { xb_st[0] = 0u; xb_st[1] = 0u; }
    const unsigned xb_x = xb_xcc_id();
    if (ph_hi - ph_lo > 1 && threadIdx.x == 0) (void)xb_add((unsigned*)(ap->ws + WS_BAR) + XB_XCNT(xb_x), 1u);
    __syncthreads();
    for (int ph = ph_lo; ph < ph_hi; ++ph) {
        asm volatile("" : "+s"(ap));
        ArgsR a = *ap;
        bf16_t* W = (bf16_t*)(a.ws + WS_W);
        bf16_t* HN = (bf16_t*)(a.ws + WS_HN);
        bf16_t* RG0 = (bf16_t*)(a.ws + WS_RG0);
        bf16_t* Y3 = (bf16_t*)(a.ws + WS_Y3);
        bf16_t* U = (bf16_t*)(a.ws + WS_HFB);
        bf16_t* YB = (bf16_t*)(a.ws + WS_QK);
        float* GMp = (float*)(a.ws + WS_GM);
        bool do_gemm = false, do_row = false;
        pg8::Gemm g{}; pg8::Order S{}; pg8::Epi E{}; RowP rp{};
        int l = 0, s = -1;
        if (ph == 0) {
            ;
        } else if (ph == 1) {
            rp = RowP{1, 0, 1, 0, 0, 0, 0, 0.f, MT, 0}; do_row = true;
        } else {
            l = (ph - 2) / 14; s = (ph - 2) - 14 * l;
            switch (s) {
            case 0: case 11:
                g = pg8::Gemm{HN, W + (s == 0 ? W_GU1 : W_GU2), MT, 5632, 1024, 0, 0}; S.init(MT, 5632, 1024, G, bidx(), 1, 0);
                E = pg8::Epi{1, RG0, FF, nullptr, -1, nullptr, nullptr, nullptr}; do_gemm = true; break;
            case 1: case 12: case 9:
                g = pg8::Gemm{s == 9 ? U : RG0, W + (s == 1 ? W_D1 : (s == 12 ? W_D2 : W_O)), MT, 1024, s == 9 ? 1024 : FF, 0, 0}; S.init(MT, 1024, g.K, G, bidx(), 1, (G == 256 && !(l == NL - 1 && s != 1)) ? TC / 256 : 0);
                E = pg8::Epi{0, YB, 1024, nullptr, -1, nullptr, nullptr, (bf16_t*)(a.ws + WS_END)}; do_gemm = true; break;
            case 3:
                g = pg8::Gemm{HN, W + W_INA, MT, PA, 1024, 0, 0}; S.init(MT, PA, 1024, G, bidx(), 1, 0);
                E = pg8::Epi{0, RG0, PA, GMp, 12, nullptr, a.in[I_QKN] + l * 128, nullptr}; do_gemm = true; break;
            case 6:
                g = pg8::Gemm{HN, W + W_INB, MT, GSW, 1024, 0, 0}; S.init(MT, GSW, 1024, G, bidx(), 1, 0);
                E = pg8::Epi{2, RG0, GSW, nullptr, -1, nullptr, nullptr, nullptr}; do_gemm = true; break;
            case 8:
                g = pg8::Gemm{Y3, W + W_B, MT, 1024, 512, (size_t)MT * 512 * 2, (size_t)1024 * 512 * 2}; S.init(MT, 1024, 512, G, bidx(), 3, 0);
                E = pg8::Epi{3, U, 1024, nullptr, -1, RG0, nullptr, nullptr}; do_gemm = true; break;
            case 2: rp = RowP{l == 0 ? 1 : 0, 1, 1, l, 0, l, 1, 0.5f, MT, G == 256}; do_row = true; break;
            case 10: rp = RowP{0, 1, 1, l, 1, l, 2, 1.0f, l == NL - 1 ? TL : MT, G == 256 && l != NL - 1}; do_row = true; break;
            case 13: rp = RowP{0, 1, l + 1 < NL ? 1 : 0, l, 2, l + 1, 0, 0.5f, l == NL - 1 ? TL : MT, G == 256 && l != NL - 1}; do_row = true; break;
            case 4: prep_phase(a, l, 2); break;
            case 5: { int nrep = PROBE_MIX_REPS; asm volatile("" : "+s"(nrep)); for (int rep = 0; rep < nrep; ++rep) mix_phase(a, l, lds, 16 + 16 * rep, rep ? 128 : 0); break; }
            case 7: readout_phase(a, l); break;
            }
        }
        if (do_gemm && l == NL - 1 && s >= 6) { g.M = TL; S.init(TL, g.N, g.K, G, bidx(), S.nz, 0); }
        if (do_gemm) {
            if (s == 8) pg8::gemm_phase<true>(lds, g, S, E); else pg8::gemm_phase<false>(lds, g, S, E);
        }
        if (do_row) row_phase(a, rp);
        {
            int cv_l = -1, lo1 = 0, hi1 = 0, lo2 = 0, hi2 = 0, wk = bidx(), nwk = G, pad = 0;
            if (ph == 0) { cv_l = 0; hi1 = 6544; pad = 1; }
            else if (ph >= 2) {
                const int l2 = (ph - 2) / 14, s2 = (ph - 2) - 14 * l2;
                if (l2 + 1 < NL) {
                    if (s2 == 13) { cv_l = l2 + 1; hi1 = 6544; pad = 1; }
                }
            }
            if (cv_l >= 0) convert_weights(a, cv_l, lds, lo1, hi1, lo2, hi2, wk, nwk, pad);
        }
        if (ph == 0) compute_mod(a, lds);
        if (ph + 1 < ph_hi) { if (ph_hi > NPH) cg::this_grid().sync();   else xcd_barrier((unsigned*)(a.ws + WS_BAR), xb_x, xb_st); }
    }
}

extern "C" void kernel_launch(void* const* d_in, const int* in_sizes, int n_in, void* d_out, int out_size, void* d_ws, size_t ws_size, hipStream_t stream) {
    static int grid = 0;
    if (grid == 0) {
        if (n_in != 19 || ws_size < WS_SCN + (size_t)MT * 8 * 16 || out_size != TL * DM) { fprintf(stderr, "kernel_launch: unexpected shapes (n_in %d, ws %zu, out %d)\n", n_in, ws_size, out_size); grid = -1; return; }
        int dev = 0, cus = 0, per_cu = 0;
        hipGetDevice(&dev); hipDeviceGetAttribute(&cus, hipDeviceAttributeMultiprocessorCount, dev);
        hipFuncSetAttribute((const void*)mk_fwd, hipFuncAttributeMaxDynamicSharedMemorySize, LDS_BYTES);
        hipOccupancyMaxActiveBlocksPerMultiprocessor(&per_cu, (const void*)mk_fwd, 512, LDS_BYTES);
        if (per_cu < 1) per_cu = 1;
        (void)hipGetLastError();
        grid = cus * per_cu;
    }
    if (grid < 0) return;
    (void)hipMemsetAsync((char*)d_ws + WS_CTL, 0, 4096 + 16384, stream);
    Args a{};
    for (int i = 0; i < 19; ++i) a.in[i] = (const float*)d_in[i];
    a.out = (float*)d_out; a.ws = (unsigned char*)d_ws;
#if MK_MULTI
    for (int ph = 0; ph < NPH; ++ph) {
        a.ph_lo = ph; a.ph_hi = ph + 1;
        hipLaunchKernelGGL(mk_fwd, dim3(grid), dim3(512), LDS_BYTES, stream, a);
    }
#else
    a.ph_lo = 0; a.ph_hi = NPH;
    void* args[] = {&a};
    hipError_t e = hipLaunchCooperativeKernel((const void*)mk_fwd, dim3(grid), dim3(512), args, LDS_BYTES, stream);
    if (e != hipSuccess) fprintf(stderr, "cooperative launch failed: %s (grid %d)\n", hipGetErrorString(e), grid);
#endif
}
```
